# Optimizing an MI355X kernel written in HIP

```python
import jax, jax.numpy as jnp
from jax import lax
import numpy as np

D_MODEL = 2048
BATCH = 4
SEQ = 8192
DEPTH = 1

PLE_DIM = 256
SB_HEADS = 8
SB_HEAD_DIM = 128
MLA_HEADS = 8
MLA_NOPE_DIM = 128
MLA_ROPE_DIM = 64
MLA_V_DIM = 128
MLA_Q_RANK = 512
MLA_KV_RANK = 512
D_FF = 4 * D_MODEL
BLOCK_Q = 128
ROPE_THETA = 10000.0
EPS = 1e-6
SB_WIDTH = SB_HEADS * SB_HEAD_DIM
MLA_WIDTH = MLA_HEADS * MLA_V_DIM
MLA_QK_DIM = MLA_NOPE_DIM + MLA_ROPE_DIM
IN_SPLITS = (SB_WIDTH, SB_WIDTH, SB_WIDTH, MLA_Q_RANK, MLA_KV_RANK, MLA_ROPE_DIM, D_MODEL, D_MODEL)
IN_WIDTH = sum(IN_SPLITS)

kernel_name = "hybrid_stickbreak_mla_gated_block"


def rmsnorm(x, g):
    xf = x.astype(jnp.float32)
    y = xf * lax.rsqrt(jnp.mean(xf * xf, axis=-1, keepdims=True) + EPS)
    return (y * g.astype(jnp.float32)).astype(x.dtype)


def rope(x, cos, sin):
    xf = x.astype(jnp.float32)
    x1, x2 = jnp.split(xf, 2, axis=-1)
    out = jnp.concatenate([x1 * cos - x2 * sin, x1 * sin + x2 * cos], axis=-1)
    return out.astype(x.dtype)


def to_blocks(t):
    b, s = t.shape[0], t.shape[1]
    return jnp.moveaxis(t.reshape(b, s // BLOCK_Q, BLOCK_Q, *t.shape[2:]), 1, 0)


def from_blocks(t):
    t = jnp.moveaxis(t, 0, 1)
    return t.reshape(t.shape[0], t.shape[1] * t.shape[2], *t.shape[3:])


def stick_breaking_attention(q, k, v):
    s_len = q.shape[1]
    scale = SB_HEAD_DIM ** -0.5
    kpos = jnp.arange(s_len)

    def block(args):
        qb, i = args
        qpos = i * BLOCK_Q + jnp.arange(BLOCK_Q)
        z = jnp.einsum('bqhd,bkhd->bhqk', qb, k, preferred_element_type=jnp.float32) * scale
        mask = kpos[None, :] < qpos[:, None]
        log_fail = jnp.where(mask, jax.nn.log_sigmoid(-z), 0.0)
        later = lax.cumsum(log_fail, axis=3, reverse=True) - log_fail
        w = jnp.where(mask, jnp.exp(jax.nn.log_sigmoid(z) + later), 0.0)
        return jnp.einsum('bhqk,bkhd->bqhd', w.astype(v.dtype), v)

    out = lax.map(block, (to_blocks(q), jnp.arange(s_len // BLOCK_Q)))
    return from_blocks(out)


def mla_attention(q_nope, q_rope, k_nope, k_rope, v):
    s_len = q_nope.shape[1]
    scale = MLA_QK_DIM ** -0.5
    kpos = jnp.arange(s_len)

    def block(args):
        qn, qr, i = args
        qpos = i * BLOCK_Q + jnp.arange(BLOCK_Q)
        s = (jnp.einsum('bqhd,bkhd->bhqk', qn, k_nope, preferred_element_type=jnp.float32)
             + jnp.einsum('bqhr,bkr->bhqk', qr, k_rope, preferred_element_type=jnp.float32)) * scale
        mask = kpos[None, :] <= qpos[:, None]
        pr = jax.nn.softmax(jnp.where(mask, s, -jnp.inf), axis=-1)
        return jnp.einsum('bhqk,bkhd->bqhd', pr.astype(v.dtype), v)

    out = lax.map(block, (to_blocks(q_nope), to_blocks(q_rope), jnp.arange(s_len // BLOCK_Q)))
    return from_blocks(out)


def hybrid_layer(x, p_i, cos, sin, g_pre_mix, w_in, g_cq, g_ckv, w_q_up, w_kv_up,
                 w_sb_o, w_mla_o, w_out, g_post_mix, g_pre_mlp, w_up, w_down,
                 g_post_mlp, w_ple, g_ple, w_ple_gate):
    b, s, _ = x.shape
    h = rmsnorm(x, g_pre_mix)
    proj = h @ w_in
    offsets = [int(o) for o in np.cumsum(IN_SPLITS)[:-1]]
    sb_q, sb_k, sb_v, c_q, c_kv, k_r, gate_sb, gate_mla = jnp.split(proj, offsets, axis=-1)

    o_sb = stick_breaking_attention(sb_q.reshape(b, s, SB_HEADS, SB_HEAD_DIM),
                                    sb_k.reshape(b, s, SB_HEADS, SB_HEAD_DIM),
                                    sb_v.reshape(b, s, SB_HEADS, SB_HEAD_DIM))
    o_sb = o_sb.reshape(b, s, SB_WIDTH) @ w_sb_o

    q = (rmsnorm(c_q, g_cq) @ w_q_up).reshape(b, s, MLA_HEADS, MLA_QK_DIM)
    q_nope = q[..., :MLA_NOPE_DIM]
    q_rope = rope(q[..., MLA_NOPE_DIM:], cos[:, :, None, :], sin[:, :, None, :])
    kv = (rmsnorm(c_kv, g_ckv) @ w_kv_up).reshape(b, s, MLA_HEADS, MLA_NOPE_DIM + MLA_V_DIM)
    k_nope, v = kv[..., :MLA_NOPE_DIM], kv[..., MLA_NOPE_DIM:]
    k_rope = rope(k_r, cos, sin)
    o_mla = mla_attention(q_nope, q_rope, k_nope, k_rope, v)
    o_mla = o_mla.reshape(b, s, MLA_WIDTH) @ w_mla_o

    mixed = jax.nn.sigmoid(gate_sb) * o_sb + jax.nn.sigmoid(gate_mla) * o_mla
    x = x + rmsnorm(mixed @ w_out, g_post_mix)

    h = rmsnorm(x, g_pre_mlp)
    u = jnp.square(jax.nn.relu(h @ w_up))
    x = x + rmsnorm(u @ w_down, g_post_mlp)

    e = rmsnorm(p_i @ w_ple, g_ple)
    x = x + jax.nn.sigmoid(x @ w_ple_gate) * e
    return x


def setup_inputs(seed: int = 0) -> dict:
    key = jax.random.key(seed)
    ks = jax.random.split(key, 24)
    f32 = jnp.float32

    def dense(k, fan_in, fan_out):
        return jax.random.normal(k, (DEPTH, fan_in, fan_out), f32) * fan_in ** -0.5

    def gain(k, n):
        return 1.0 + 0.02 * jax.random.normal(k, (DEPTH, n), f32)

    x = jax.random.normal(ks[0], (BATCH, SEQ, D_MODEL), f32)
    p = jax.random.normal(ks[1], (DEPTH, BATCH, SEQ, PLE_DIM), f32)
    offset = jax.random.randint(ks[2], (BATCH, 1), 0, 1024, dtype=jnp.int32)
    positions = (jnp.arange(SEQ, dtype=jnp.int32)[None, :] + offset).astype(jnp.int32)
    return {
        "x": x,
        "p": p,
        "positions": positions,
        "g_pre_mix": gain(ks[3], D_MODEL),
        "w_in": dense(ks[4], D_MODEL, IN_WIDTH),
        "g_cq": gain(ks[5], MLA_Q_RANK),
        "g_ckv": gain(ks[6], MLA_KV_RANK),
        "w_q_up": dense(ks[7], MLA_Q_RANK, MLA_HEADS * MLA_QK_DIM),
        "w_kv_up": dense(ks[8], MLA_KV_RANK, MLA_HEADS * (MLA_NOPE_DIM + MLA_V_DIM)),
        "w_sb_o": dense(ks[9], SB_WIDTH, D_MODEL),
        "w_mla_o": dense(ks[10], MLA_WIDTH, D_MODEL),
        "w_out": dense(ks[11], D_MODEL, D_MODEL),
        "g_post_mix": gain(ks[12], D_MODEL),
        "g_pre_mlp": gain(ks[13], D_MODEL),
        "w_up": dense(ks[14], D_MODEL, D_FF),
        "w_down": dense(ks[15], D_FF, D_MODEL),
        "g_post_mlp": gain(ks[16], D_MODEL),
        "w_ple": dense(ks[17], PLE_DIM, D_MODEL),
        "g_ple": gain(ks[18], D_MODEL),
        "w_ple_gate": dense(ks[19], D_MODEL, D_MODEL),
    }


def reference(x, p, positions, g_pre_mix, w_in, g_cq, g_ckv, w_q_up, w_kv_up,
              w_sb_o, w_mla_o, w_out, g_post_mix, g_pre_mlp, w_up, w_down,
              g_post_mlp, w_ple, g_ple, w_ple_gate):
    half = MLA_ROPE_DIM // 2
    inv_freq = ROPE_THETA ** (-jnp.arange(half, dtype=jnp.float32) / half)
    ang = positions.astype(jnp.float32)[..., None] * inv_freq
    cos, sin = jnp.cos(ang), jnp.sin(ang)
    for i in range(DEPTH):
        x = hybrid_layer(x, p[i], cos, sin, g_pre_mix[i], w_in[i], g_cq[i], g_ckv[i],
                         w_q_up[i], w_kv_up[i], w_sb_o[i], w_mla_o[i], w_out[i],
                         g_post_mix[i], g_pre_mlp[i], w_up[i], w_down[i], g_post_mlp[i],
                         w_ple[i], g_ple[i], w_ple_gate[i])
    return x
```

```cpp
#include <hip/hip_runtime.h>
#include <hip/hip_bf16.h>
#include <hip/hip_cooperative_groups.h>
#include <cstdio>
#include <cstdint>
namespace cg = cooperative_groups;
namespace pg8 {
#define PG8_LAS __attribute__((address_space(3)))
typedef unsigned short bf16_t;
typedef short bf16x8 __attribute__((ext_vector_type(8)));
typedef float f32x4 __attribute__((ext_vector_type(4)));
typedef unsigned u32x4 __attribute__((ext_vector_type(4)));
constexpr int BM = 256, BK = 64, HALF = 128, HTB = HALF * BK * 2  , STAGE_BYTES = 8 * HTB, NXCD = 8, WGM = 8;

__host__ __device__ __forceinline__ int lds_byte(int r, int c) { const int st = (r >> 4) * 2 + (c >> 5), rr = r & 15, cc = c & 31, ob = rr * 64 + cc * 2; return st * 1024 + (ob ^ (((ob >> 9) & 1) << 5)); }
__host__ __device__ __forceinline__ void stage_rc(int b, int& R, int& C) { const int st = b / 1024, sb = b % 1024, swz = sb ^ (((sb >> 9) & 1) << 5); R = (st >> 1) * 16 + swz / 64; C = (st & 1) * 32 + (swz % 64) / 2; }
__host__ __device__ __forceinline__ int perm32(int rho) { const int n = rho >> 4, i = rho & 15; return 8 * (i >> 2) + 4 * n + (i & 3); }

struct Unit { int pm, pn; };
struct Gemm { const bf16_t* A; const bf16_t* Bt; int M, N, K; };
struct StaticOrder {
    int nM, nN, nwg, G, c;
    __host__ __device__ void init(int M, int N, int G_, int c_) { nM = M / BM; nN = N / BM; nwg = nM * nN; G = G_; c = c_; }
    __host__ __device__ bool next(int i, Unit& u) const {
        const long L = (long)i * G + c; if (L >= nwg) return false;
        int wgid = (int)L; { const int q = nwg / NXCD, r = nwg % NXCD, xcd = wgid % NXCD, off = wgid / NXCD; wgid = (xcd < r ? xcd * (q + 1) : r * (q + 1) + (xcd - r) * q) + off; }
        const int nig = WGM * nN, gid = wgid / nig, fm = gid * WGM, gsz = (nM - fm) < WGM ? (nM - fm) : WGM;
        u.pm = fm + ((wgid % nig) % gsz); u.pn = (wgid % nig) / gsz; return true;
    }
    __device__ __forceinline__ void a_ready(const Unit&) const {}
    __device__ __forceinline__ void done(const Unit&) const {}
};
typedef float f32x2_cv __attribute__((ext_vector_type(2))); typedef __bf16 bf16x2_cv __attribute__((ext_vector_type(2)));
__device__ __forceinline__ unsigned cvt_pk_bf16(float lo, float hi) { f32x2_cv v = {lo, hi}; bf16x2_cv b = __builtin_convertvector(v, bf16x2_cv); return __builtin_bit_cast(unsigned, b); }
typedef float f32x2 __attribute__((ext_vector_type(2)));
template <class Epi, class Sched, bool ALIGN_EPI = false, bool SP2 = false>
__device__ __forceinline__ void gemm_phase(PG8_LAS unsigned char* lds, const Gemm g, const Sched& S, const Epi& E) {
    int tid_ = threadIdx.x; asm volatile("" : "+v"(tid_));
    const int tid = tid_, wid = __builtin_amdgcn_readfirstlane(tid >> 6), lane = tid & 63, wr = wid >> 2, wc = wid & 3, fr = lane & 15, fq = lane >> 4;
    const int K = g.K, nt = K / BK;
    unsigned voffA[2], voffB[2];
#pragma unroll
    for (int i = 0; i < 2; ++i) { int R, C; stage_rc(tid * 16 + i * 8192, R, C); const int Rb = Epi::PERM ? ((R & ~31) + perm32(R & 31)) : R;
        voffA[i] = (unsigned)(R * K + C) * 2u; voffB[i] = (unsigned)(Rb * K + C) * 2u; }
    const size_t kstep = (size_t)(BK * 2);
    const size_t hstep = (size_t)HALF * K * 2;
    const size_t tstep = 2 * hstep;
    const unsigned ldsw = (unsigned)wid * 1024u;
    const int aoff = lds_byte(wr * 64 + fr, fq * 8), boff = lds_byte(wc * 32 + fr, fq * 8);
#define PG8_SA(b, h) (((b) * 2 + (h)) * HTB)
#define PG8_SB(b, h) ((4 + (b) * 2 + (h)) * HTB)
#define PG8_STAGE(bufoff, gbase, voff) do { _Pragma("unroll") for (int _i = 0; _i < 2; ++_i) \
        __builtin_amdgcn_global_load_lds((const unsigned*)((const char*)(gbase) + (voff)[_i]), (PG8_LAS unsigned*)(lds + (bufoff) + ldsw + _i * 8192), 16, 0, 0); } while (0)
#define PG8_LDA(dst, b, h) do { _Pragma("unroll") for (int m = 0; m < 4; ++m) _Pragma("unroll") for (int k = 0; k < 2; ++k) dst[m][k] = *(const PG8_LAS bf16x8*)(lds + PG8_SA(b, h) + aoff + m * 2048 + k * 1024); } while (0)
#define PG8_LDB(dst, b, h) do { _Pragma("unroll") for (int n = 0; n < 2; ++n) _Pragma("unroll") for (int k = 0; k < 2; ++k) dst[n][k] = *(const PG8_LAS bf16x8*)(lds + PG8_SB(b, h) + boff + n * 2048 + k * 1024); } while (0)
#define PG8_MMA(ai, bj, At, Bt) do { __builtin_amdgcn_s_setprio(1); _Pragma("unroll") for (int m = 0; m < 4; ++m) _Pragma("unroll") for (int n = 0; n < 2; ++n) _Pragma("unroll") for (int k = 0; k < 2; ++k) \
        acc[ai][bj][m][n] = __builtin_amdgcn_mfma_f32_16x16x32_bf16(Bt[n][k], At[m][k], acc[ai][bj][m][n], 0, 0, 0); __builtin_amdgcn_s_setprio(0); } while (0)
#define PG8_WAIT_V(n) asm volatile("s_waitcnt vmcnt(" #n ")" ::: "memory")
#define PG8_WAIT_L(n) asm volatile("s_waitcnt lgkmcnt(" #n ")" ::: "memory")
#define PG8_BAR __builtin_amdgcn_s_barrier()
#define PG8_SCHED __builtin_amdgcn_sched_barrier(0)
    Unit cur, nxt; int ui = 0;
    if (!S.next(0, cur)) return;
    f32x4 acc[2][2][4][2];
#pragma unroll
    for (int a = 0; a < 2; ++a)
#pragma unroll
        for (int b = 0; b < 2; ++b)
#pragma unroll
            for (int m = 0; m < 4; ++m)
#pragma unroll
                for (int n = 0; n < 2; ++n) acc[a][b][m][n] = (f32x4){0.f, 0.f, 0.f, 0.f};
    bf16x8 At[4][2], B0[2][2], B1[2][2];
    const char* cA = (const char*)g.A + (size_t)cur.pm * tstep; const char* cB = (const char*)g.Bt + (size_t)cur.pn * tstep;
    S.a_ready(cur);
    if constexpr (SP2) {
        PG8_STAGE(PG8_SB(0, 0), cB, voffB); PG8_STAGE(PG8_SB(0, 1), cB + hstep, voffB); PG8_STAGE(PG8_SA(0, 0), cA, voffA); PG8_STAGE(PG8_SA(0, 1), cA + hstep, voffA);
        if (wr == 1) PG8_BAR;
        PG8_WAIT_V(2); PG8_BAR;
        PG8_STAGE(PG8_SB(1, 0), cB + kstep, voffB); PG8_STAGE(PG8_SA(1, 0), cA + kstep, voffA); PG8_STAGE(PG8_SB(1, 1), cB + hstep + kstep, voffB);
        PG8_WAIT_V(6); PG8_BAR;
    } else {
        PG8_STAGE(PG8_SB(0, 0), cB, voffB); PG8_STAGE(PG8_SA(0, 0), cA, voffA); PG8_STAGE(PG8_SB(0, 1), cB + hstep, voffB); PG8_STAGE(PG8_SA(0, 1), cA + hstep, voffA);
        if (wr == 1) PG8_BAR;
        PG8_WAIT_V(4); PG8_BAR;
        PG8_STAGE(PG8_SB(1, 0), cB + kstep, voffB); PG8_STAGE(PG8_SA(1, 0), cA + kstep, voffA); PG8_STAGE(PG8_SB(1, 1), cB + hstep + kstep, voffB);
        PG8_WAIT_V(6); PG8_BAR;
    }
    for (;;) {
        const bool has_next = S.next(ui + 1, nxt);
        const char* nA = has_next ? (const char*)g.A + (size_t)nxt.pm * tstep : cA; const char* nB = has_next ? (const char*)g.Bt + (size_t)nxt.pn * tstep : cB;
        for (int t = 0; t < nt; t += 2) {
            const bool last = (t == nt - 2);
            const char* a1 = cA + (size_t)(t + 1) * kstep;
            const char* a2 = last ? nA : cA + (size_t)(t + 2) * kstep; const char* b2 = last ? nB : cB + (size_t)(t + 2) * kstep;
            const char* a3 = a2 + kstep; const char* b3 = b2 + kstep;
            if (last && has_next) S.a_ready(nxt);
            if constexpr (SP2) {
            PG8_LDB(B0, 0, 0); PG8_LDB(B1, 0, 1); PG8_SCHED; PG8_LDA(At, 0, 0); PG8_STAGE(PG8_SA(1, 1), a1 + hstep, voffA);
            PG8_WAIT_V(8); PG8_WAIT_L(0); PG8_BAR; PG8_MMA(0, 0, At, B0); PG8_MMA(0, 1, At, B1); PG8_BAR; PG8_SCHED;
            PG8_LDA(At, 0, 1); PG8_STAGE(PG8_SB(0, 0), b2, voffB); PG8_STAGE(PG8_SB(0, 1), b2 + hstep, voffB); PG8_STAGE(PG8_SA(0, 0), a2, voffA);
            PG8_WAIT_V(8); PG8_WAIT_L(0); PG8_BAR; PG8_MMA(1, 0, At, B0); PG8_MMA(1, 1, At, B1); PG8_BAR; PG8_SCHED;
            PG8_LDB(B0, 1, 0); PG8_LDB(B1, 1, 1); PG8_SCHED; PG8_LDA(At, 1, 0); PG8_STAGE(PG8_SA(0, 1), a2 + hstep, voffA);
            PG8_WAIT_V(8); PG8_WAIT_L(0); PG8_BAR; PG8_MMA(0, 0, At, B0); PG8_MMA(0, 1, At, B1); PG8_BAR; PG8_SCHED;
            PG8_LDA(At, 1, 1); PG8_STAGE(PG8_SB(1, 0), b3, voffB); PG8_STAGE(PG8_SB(1, 1), b3 + hstep, voffB); PG8_STAGE(PG8_SA(1, 0), a3, voffA);
            PG8_WAIT_V(8); PG8_WAIT_L(0); PG8_BAR; PG8_MMA(1, 0, At, B0); PG8_MMA(1, 1, At, B1); PG8_BAR; PG8_SCHED;
            } else {
            PG8_LDB(B0, 0, 0); PG8_SCHED; PG8_LDA(At, 0, 0); PG8_STAGE(PG8_SA(1, 1), a1 + hstep, voffA);
            PG8_WAIT_L(8); PG8_BAR; PG8_WAIT_L(0); PG8_MMA(0, 0, At, B0); PG8_BAR; PG8_SCHED;
            PG8_LDB(B1, 0, 1); PG8_STAGE(PG8_SB(0, 0), b2, voffB);
            PG8_BAR; PG8_WAIT_L(0); PG8_MMA(0, 1, At, B1); PG8_BAR;
            PG8_LDA(At, 0, 1); PG8_STAGE(PG8_SA(0, 0), a2, voffA);
            PG8_BAR; PG8_WAIT_L(0); PG8_MMA(1, 0, At, B0); PG8_BAR; PG8_SCHED;
            PG8_STAGE(PG8_SB(0, 1), b2 + hstep, voffB);
            PG8_WAIT_V(6); PG8_BAR; PG8_MMA(1, 1, At, B1); PG8_BAR;
            PG8_LDB(B0, 1, 0); PG8_SCHED; PG8_LDA(At, 1, 0); PG8_STAGE(PG8_SA(0, 1), a2 + hstep, voffA);
            PG8_WAIT_L(8); PG8_BAR; PG8_WAIT_L(0); PG8_MMA(0, 0, At, B0); PG8_BAR; PG8_SCHED;
            PG8_LDB(B1, 1, 1); PG8_STAGE(PG8_SB(1, 0), b3, voffB);
            PG8_BAR; PG8_WAIT_L(0); PG8_MMA(0, 1, At, B1); PG8_BAR;
            PG8_LDA(At, 1, 1); PG8_STAGE(PG8_SA(1, 0), a3, voffA);
            PG8_BAR; PG8_WAIT_L(0); PG8_MMA(1, 0, At, B0); PG8_BAR; PG8_SCHED;
            PG8_STAGE(PG8_SB(1, 1), b3 + hstep, voffB);
            PG8_WAIT_V(6); PG8_BAR; PG8_MMA(1, 1, At, B1); PG8_BAR;
            }
        }
        if constexpr (ALIGN_EPI) { if (wr == 0) PG8_BAR; }
        if constexpr (!Epi::AFTER_DRAIN) { E(acc, cur, wr, wc, fr, fq); S.done(cur); }
        if (!has_next) break;
#pragma unroll
        for (int a = 0; a < 2; ++a)
#pragma unroll
            for (int b = 0; b < 2; ++b)
#pragma unroll
                for (int m = 0; m < 4; ++m)
#pragma unroll
                    for (int n = 0; n < 2; ++n) acc[a][b][m][n] = (f32x4){0.f, 0.f, 0.f, 0.f};
        cur = nxt; cA = nA; cB = nB; ++ui;
        if constexpr (ALIGN_EPI) { if (wr == 1) PG8_BAR; }
    }
    PG8_WAIT_V(0);
    if constexpr (!ALIGN_EPI) { if (wr == 0) PG8_BAR; }
    PG8_BAR;
    if constexpr (Epi::AFTER_DRAIN) { E.fused(acc, cur, wr, wc, fr, fq, lds, wid, lane); S.done(cur); }
#undef PG8_SA
#undef PG8_SB
#undef PG8_STAGE
#undef PG8_LDA
#undef PG8_LDB
#undef PG8_MMA
#undef PG8_WAIT_V
#undef PG8_WAIT_L
#undef PG8_BAR
#undef PG8_SCHED
}
}
constexpr int T_TOK = 32768, SEQ = 8192, DM = 2048, NH = 8, FF = 8192, PLE = 256;
constexpr int NIN = 8448;
constexpr float EPS = 1e-6f;
constexpr float LOG2E = 1.4426950408889634f;
constexpr float SB_QSCALE = 0.08838834764831845f * LOG2E;
constexpr size_t MiB = 1u << 20;
constexpr size_t WS_BAR = 768 * 1024;
constexpr size_t WS_SSQ = 0;
constexpr size_t WS_W = 1 * MiB;
constexpr size_t OFF_WIN = 0, OFF_WQ = 17301504, OFF_WKV = 18087936, OFF_WSBO = 19136512, OFF_WMLAO = 21233664, OFF_WOUT = 23330816,
                 OFF_WUP = 27525120, OFF_WDOWN = 44302336, OFF_WPLE = 61079552, OFF_WPG = 61603840;
constexpr size_t WS_XN = 128 * MiB;
constexpr size_t WS_SBQ = 256 * MiB, WS_SBK = 320 * MiB, WS_SBV = 384 * MiB, WS_CQ = 448 * MiB, WS_CKV = 480 * MiB, WS_QMLA = 512 * MiB,
                 WS_KN = 608 * MiB, WS_VMLA = 672 * MiB, WS_KROPE = 736 * MiB, WS_OSB = 768 * MiB, WS_OMLA = 832 * MiB, WS_E = 896 * MiB;
constexpr size_t WS_MIXED = 256 * MiB, WS_Y = 384 * MiB, WS_PB = 768 * MiB, WS_U = 256 * MiB, WS_DN = 768 * MiB, WS_END = 1024 * MiB;
constexpr int LDS_BYTES = 132096;

typedef unsigned short bf16_t;
typedef float f32x4 __attribute__((ext_vector_type(4)));
typedef unsigned u32x4 __attribute__((ext_vector_type(4)));
typedef unsigned u32x2 __attribute__((ext_vector_type(2)));
#define LAS __attribute__((address_space(3)))

__device__ __forceinline__ unsigned pk2(float lo, float hi) { return pg8::cvt_pk_bf16(lo, hi); }
__device__ __forceinline__ float bf_lo(unsigned w) { return __uint_as_float(w << 16); }
__device__ __forceinline__ float bf_hi(unsigned w) { return __uint_as_float(w & 0xffff0000u); }
__device__ __forceinline__ void store8(bf16_t* dst, const float* v) { u32x4 w; w.x = pk2(v[0], v[1]); w.y = pk2(v[2], v[3]); w.z = pk2(v[4], v[5]); w.w = pk2(v[6], v[7]); *(u32x4*)dst = w; }
__device__ __forceinline__ void store8_nt(bf16_t* dst, const float* v) { u32x4 w; w.x = pk2(v[0], v[1]); w.y = pk2(v[2], v[3]); w.z = pk2(v[4], v[5]); w.w = pk2(v[6], v[7]); __builtin_nontemporal_store(w, (u32x4*)dst); }
__device__ __forceinline__ void load8(const bf16_t* src, float* v) { const u32x4 w = *(const u32x4*)src; v[0] = bf_lo(w.x); v[1] = bf_hi(w.x); v[2] = bf_lo(w.y); v[3] = bf_hi(w.y); v[4] = bf_lo(w.z); v[5] = bf_hi(w.z); v[6] = bf_lo(w.w); v[7] = bf_hi(w.w); }
__device__ __forceinline__ float sigmoidf_(float v) { return __builtin_amdgcn_rcpf(1.f + __builtin_amdgcn_exp2f(-v * LOG2E)); }
__device__ __forceinline__ float wave_sum(float v) {
#pragma unroll
    for (int o = 1; o < 64; o <<= 1) v += __shfl_xor(v, o);
    return v;
}
__device__ __forceinline__ void rope_pair(float& a, float& b, int pos, int i) {
    const float inv = __builtin_amdgcn_exp2f(-(float)i * 0.41524101186092029f);
    const float ang = (float)pos * inv;
    double rev = (double)ang * 0.15915494309189535;
    rev -= __builtin_rint(rev);
    const float fr = (float)rev;
    const float s = __builtin_amdgcn_sinf(fr), c = __builtin_amdgcn_cosf(fr);
    const float na = a * c - b * s, nb = a * s + b * c; a = na; b = nb;
}

struct EpiArgs {
    bf16_t* o0; bf16_t* o1; bf16_t* o2;
    bf16_t* o3; bf16_t* o4; bf16_t* o5; bf16_t* o6; bf16_t* o7;
    float* ssq0; float* ssq1;
    const bf16_t* g0; const bf16_t* g1;
    const int* pos; float* outf; const float* gv;
};
enum { EK_P1 = 0, EK_Q = 1, EK_KV = 2, EK_MIX1 = 3, EK_MIX2 = 4, EK_SSQ = 5, EK_UP = 6, EK_FIN = 7 };
template <int KIND> struct Epi {
    static constexpr bool PERM = true, AFTER_DRAIN = false;
    EpiArgs a;
    __device__ __forceinline__ void operator()(const pg8::f32x4 (&acc)[2][2][4][2], const pg8::Unit& u, int wr, int wc, int fr, int fq) const {
        const int pn = u.pn;
#pragma unroll
        for (int ai = 0; ai < 2; ++ai)
#pragma unroll
            for (int m = 0; m < 4; ++m) {
                const int row = u.pm * 256 + ai * 128 + wr * 64 + m * 16 + fr;
                const int bb = row >> 13, ss = row & 8191;
                float ssq = 0.f;
                float rs = 1.f;
                if constexpr (KIND == EK_Q || KIND == EK_KV) rs = __builtin_amdgcn_rsqf(a.ssq0[row] * (1.f / 512.f) + EPS);
                if constexpr (KIND == EK_FIN) rs = __builtin_amdgcn_rsqf(a.ssq0[row] * (1.f / 2048.f) + EPS);
#pragma unroll
                for (int bj = 0; bj < 2; ++bj) {
                    const int cl = bj * 128 + wc * 32 + fq * 8;
                    float v[8];
#pragma unroll
                    for (int j = 0; j < 4; ++j) { v[j] = acc[ai][bj][m][0][j]; v[4 + j] = acc[ai][bj][m][1][j]; }
                    if constexpr (KIND == EK_P1) {
                        if (pn < 12) {
                            const int t = pn >> 2, c = (pn & 3) * 256 + cl, h = c >> 7, d = c & 127;
                            if (t == 0) {
#pragma unroll
                                for (int j = 0; j < 8; ++j) v[j] *= SB_QSCALE;
                            }
                            bf16_t* base = t == 0 ? a.o0 : (t == 1 ? a.o1 : a.o2);
                            store8(base + ((size_t)((bb * NH + h) * SEQ + ss)) * 128 + d, v);
                        } else if (pn < 16) {
                            const int t = (pn - 12) >> 1, c = ((pn - 12) & 1) * 256 + cl;
#pragma unroll
                            for (int j = 0; j < 8; ++j) ssq += v[j] * v[j];
                            store8((t ? a.o4 : a.o3) + (size_t)row * 512 + c, v);
                        } else if (pn == 16) {
                            if (cl < 64) {
                                const int p = a.pos[row];
#pragma unroll
                                for (int j = 0; j < 4; ++j) rope_pair(v[2 * j], v[2 * j + 1], p, (cl >> 1) + j);
                                store8(a.o5 + (size_t)row * 64 + cl, v);
                            }
                        } else {
                            const int t = (pn - 17) >> 3, c = ((pn - 17) & 7) * 256 + cl;
#pragma unroll
                            for (int j = 0; j < 8; ++j) v[j] = sigmoidf_(v[j]);
                            store8_nt((t ? a.o7 : a.o6) + (size_t)row * 2048 + c, v);
                        }
                    } else if constexpr (KIND == EK_Q) {
                        const int c = pn * 256 + cl, h = c / 192, dd = c - h * 192;
#pragma unroll
                        for (int j = 0; j < 8; ++j) v[j] *= rs;
                        if (dd >= 128) {
                            const int p = a.pos[row];
#pragma unroll
                            for (int j = 0; j < 4; ++j) rope_pair(v[2 * j], v[2 * j + 1], p, ((dd - 128) >> 1) + j);
                        }
                        store8(a.o0 + ((size_t)((bb * NH + h) * SEQ + ss)) * 192 + dd, v);
                    } else if constexpr (KIND == EK_KV) {
#pragma unroll
                        for (int j = 0; j < 8; ++j) v[j] *= rs;
                        store8((bj ? a.o1 : a.o0) + ((size_t)((bb * NH + pn) * SEQ + ss)) * 128 + (cl & 127), v);
                    } else if constexpr (KIND == EK_MIX1) {
                        const size_t off = (size_t)row * 2048 + pn * 256 + cl; float g[8]; load8(a.g0 + off, g);
#pragma unroll
                        for (int j = 0; j < 8; ++j) v[j] *= g[j];
                        store8(a.o0 + off, v);
                    } else if constexpr (KIND == EK_MIX2) {
                        const size_t off = (size_t)row * 2048 + pn * 256 + cl; float g[8], pr[8]; load8(a.g0 + off, g); load8(a.o0 + off, pr);
#pragma unroll
                        for (int j = 0; j < 8; ++j) v[j] = pr[j] + v[j] * g[j];
                        store8(a.o0 + off, v);
                    } else if constexpr (KIND == EK_SSQ) {
#pragma unroll
                        for (int j = 0; j < 8; ++j) ssq += v[j] * v[j];
                        store8(a.o0 + (size_t)row * 2048 + pn * 256 + cl, v);
                    } else if constexpr (KIND == EK_UP) {
#pragma unroll
                        for (int j = 0; j < 8; ++j) { const float r = fmaxf(v[j], 0.f); v[j] = r * r; }
                        { u32x4 w; w.x = pk2(v[0], v[1]); w.y = pk2(v[2], v[3]); w.z = pk2(v[4], v[5]); w.w = pk2(v[6], v[7]); __builtin_nontemporal_store(w, (u32x4*)(a.o0 + (size_t)row * FF + pn * 256 + cl)); }
                    } else if constexpr (KIND == EK_FIN) {
                        const int c = pn * 256 + cl; const size_t off = (size_t)row * 2048 + c; float e[8]; load8(a.g0 + off, e);
                        const f32x4 x0 = *(const f32x4*)(a.outf + off), x1 = *(const f32x4*)(a.outf + off + 4);
                        const f32x4 g0 = *(const f32x4*)(a.gv + c), g1 = *(const f32x4*)(a.gv + c + 4);
                        f32x4 r0, r1;
#pragma unroll
                        for (int j = 0; j < 4; ++j) { r0[j] = x0[j] + sigmoidf_(v[j]) * (e[j] * rs * g0[j]); r1[j] = x1[j] + sigmoidf_(v[4 + j]) * (e[4 + j] * rs * g1[j]); }
                        *(f32x4*)(a.outf + off) = r0; *(f32x4*)(a.outf + off + 4) = r1;
                    }
                }
                if constexpr (KIND == EK_P1) {
                    if (pn >= 12 && pn < 16) { ssq += __shfl_xor(ssq, 16); ssq += __shfl_xor(ssq, 32); if (fq == 0) atomicAdd((pn >= 14 ? a.ssq1 : a.ssq0) + row, ssq); }
                }
                if constexpr (KIND == EK_SSQ) { ssq += __shfl_xor(ssq, 16); ssq += __shfl_xor(ssq, 32); if (fq == 0) atomicAdd(a.ssq0 + row, ssq); }
            }
    }
};
#define XB_TMO      128
#define XB_XCNT(j)  (256  + 64 * (j))
#define XB_XSUB(j)  (1280 + 64 * (j))
#define XB_XGEN(j)  (2304 + 64 * (j))
#define XB_TOP      3328
#define XB_TOPGEN   3392
#define XCD_BAR_WORDS 3456
#define XB_SPIN_CAP (1u << 18)

__device__ __forceinline__ unsigned xb_ld(unsigned* p)              { return __hip_atomic_load(p, __ATOMIC_RELAXED, __HIP_MEMORY_SCOPE_AGENT); }
__device__ __forceinline__ unsigned xb_add(unsigned* p, unsigned v) { return __hip_atomic_fetch_add(p, v, __ATOMIC_RELAXED, __HIP_MEMORY_SCOPE_AGENT); }
__device__ __forceinline__ unsigned xb_xcc_id() { return (unsigned)__builtin_amdgcn_s_getreg((3 << 11) | 20) & 0xFu; }
#define XB_SPIN(cond, bar) do { unsigned _sp = 0; while (cond) { __builtin_amdgcn_s_sleep(1); \
    if ((++_sp & 255u) == 0u) { if (xb_ld(&(bar)[XB_TMO])) break; if (_sp > XB_SPIN_CAP) { atomicAdd(&(bar)[XB_TMO], 1u); break; } } } } while (0)

struct XcdBarrier {
    unsigned* bar; unsigned x;
    volatile LAS unsigned* st;
};

__device__ __forceinline__ XcdBarrier xcd_barrier_post(unsigned* bar, volatile LAS unsigned* st) {
    XcdBarrier b; b.bar = bar; b.x = xb_xcc_id(); b.st = st;
    if (threadIdx.x == 0) (void)xb_add(&bar[XB_XCNT(b.x)], 1u);
    return b;
}
__device__ __forceinline__ void xcd_barrier_complete(unsigned* bar, unsigned x, unsigned& nloc, unsigned& nx) {
    const unsigned G = gridDim.x * gridDim.y * gridDim.z;
    unsigned sum, cnt, mine, sp = 0u;
    for (;;) {
        sum = 0u; cnt = 0u; mine = 0u;
#pragma unroll
        for (unsigned j = 0; j < 16; ++j) { const unsigned c = xb_ld(&bar[XB_XCNT(j)]); sum += c; cnt += (c > 0u) ? 1u : 0u; mine = (j == x) ? c : mine; }
        if (sum == G) break;
        __builtin_amdgcn_s_sleep(1);
        if ((++sp & 255u) == 0u) { if (xb_ld(&bar[XB_TMO])) break; if (sp > XB_SPIN_CAP) { atomicAdd(&bar[XB_TMO], 1u); break; } }
    }
    nloc = mine > 0u ? mine : 1u; nx = cnt > 0u ? cnt : 1u;
}

__device__ __forceinline__ void xcd_barrier(const XcdBarrier& b) {
    asm volatile("s_waitcnt vmcnt(0)" ::: "memory");
    __syncthreads();
    if (threadIdx.x == 0) {
        unsigned* bar = b.bar;
        __builtin_amdgcn_s_waitcnt(0);
        unsigned nloc = b.st[0], nx = b.st[1];
        if (nloc == 0u) { xcd_barrier_complete(bar, b.x, nloc, nx); b.st[0] = nloc; b.st[1] = nx; }
        const unsigned old = xb_add(&bar[XB_XSUB(b.x)], 1u);
        const unsigned gen = old / nloc;
        if (old + 1u == (gen + 1u) * nloc) {
            __builtin_amdgcn_fence(__ATOMIC_RELEASE, "agent");
            asm volatile("s_waitcnt vmcnt(0)" ::: "memory");
            const unsigned og = xb_add(&bar[XB_TOP], 1u);
            const unsigned tg = og / nx;
            if (og + 1u == (tg + 1u) * nx) xb_add(&bar[XB_TOPGEN], 1u);
            else XB_SPIN(xb_ld(&bar[XB_TOPGEN]) == tg, bar);
            __builtin_amdgcn_fence(__ATOMIC_ACQUIRE, "agent");
            xb_add(&bar[XB_XGEN(b.x)], 1u);
            asm volatile("s_waitcnt vmcnt(0)" ::: "memory");
        } else {
            XB_SPIN(xb_ld(&bar[XB_XGEN(b.x)]) == gen, bar);
            __builtin_amdgcn_fence(__ATOMIC_ACQUIRE, "agent");
            asm volatile("s_waitcnt vmcnt(0)" ::: "memory");
        }
    }
    __syncthreads();
}
namespace att {
using bf16 = __hip_bfloat16;
typedef short bf16x8 __attribute__((ext_vector_type(8)));
typedef short s16x4 __attribute__((ext_vector_type(4)));
typedef float f32x16 __attribute__((ext_vector_type(16)));
typedef float f32x4 __attribute__((ext_vector_type(4)));
typedef unsigned u32x4 __attribute__((ext_vector_type(4)));
template <class A, class Bt> struct same_t { static constexpr bool v = false; };
template <class A> struct same_t<A, A> { static constexpr bool v = true; };
constexpr int D = 128, NW = 8, QBLK = 32, KVBLK = 64, QB = NW * QBLK;
constexpr int SHM_V = KVBLK * D * 2, SHM_K = KVBLK * D * 2, SHM_KR = 64 * 144;
constexpr float SCALE = 0.07216878364870323f;
constexpr float THR = 8.f;
constexpr bool WSKIP = false;
#define KSWZ(row, colB) ((row) * 256 + ((colB) ^ (((row) & 7) << 4)))
#define SBAR() __builtin_amdgcn_sched_barrier(0)
__device__ __forceinline__ int v_st(int k, int c) { const int kk = (k & ~0xC) | ((k & 4) << 1) | ((k & 8) >> 1); return ((kk >> 3) * 4 + (c >> 5)) * 512 + ((kk & 7) * 32 + (c & 31)) * 2; }
__device__ __forceinline__ int v_rd_base(int lane) { return ((lane & 3) << 3) | (((lane >> 2) & 3) << 6) | (((lane >> 4) & 1) << 5) | (((lane >> 5) & 1) << 8); }
constexpr int v_rd_off(int d0, int ks, int half) { return d0 * 512 + ks * 4096 + half * 2048; }
__device__ __forceinline__ int crow(int r, int hi) { return (r & 3) + 8 * (r >> 2) + 4 * hi; }
__device__ __forceinline__ unsigned cvtpk(float lo, float hi) {
    typedef float f32x2_cv __attribute__((ext_vector_type(2))); typedef __bf16 bf16x2_cv __attribute__((ext_vector_type(2)));
    f32x2_cv v = {lo, hi}; bf16x2_cv b = __builtin_convertvector(v, bf16x2_cv); return __builtin_bit_cast(unsigned, b);
}
__device__ __forceinline__ bf16x8 pack8(f32x4 a, f32x4 b) {
    u32x4 w = {cvtpk(a[0], a[1]), cvtpk(a[2], a[3]), cvtpk(b[0], b[1]), cvtpk(b[2], b[3])};
    return *reinterpret_cast<bf16x8*>(&w);
}
template <class T> __device__ __forceinline__ bf16x8 load8(const T* p) {
    if constexpr (same_t<T, float>::v) { return pack8(*(const f32x4*)p, *(const f32x4*)(p + 4)); }
    else { return *reinterpret_cast<const bf16x8*>(p); }
}
__device__ __forceinline__ void mask_tile(f32x16& p0, f32x16& p1, int dq, unsigned W) {
    const float NEG = -__builtin_inff();
#pragma unroll
    for (int r = 0; r < 16; ++r) {
        const int c = (r & 3) + 8 * (r >> 2);
        if ((unsigned)(dq - c) >= W) p0[r] = NEG;
        if ((unsigned)(dq - c - 32) >= W) p1[r] = NEG;
    }
}
__device__ __forceinline__ void partialSM(f32x16& p0, f32x16& p1, float& m_reg, float& mn, float& alpha) {
    float pmax = p0[0]; for (int r = 1; r < 16; ++r) pmax = fmaxf(pmax, p0[r]); for (int r = 0; r < 16; ++r) pmax = fmaxf(pmax, p1[r]);
    { auto rr = __builtin_amdgcn_permlane32_swap(__float_as_uint(pmax), __float_as_uint(pmax), false, false);
      pmax = fmaxf(__uint_as_float(rr[0]), __uint_as_float(rr[1])); }
    constexpr float C2 = 1.4426950408889634f * SCALE;
    if (__builtin_expect(__all((pmax - m_reg) * SCALE <= THR), 1)) { mn = m_reg; alpha = 1.f; }
    else { mn = fmaxf(m_reg, pmax); alpha = __builtin_amdgcn_exp2f((m_reg - mn) * C2); m_reg = mn; }
    const float mnL = -mn * C2;
    for (int r = 0; r < 16; ++r) p0[r] = fmaf(p0[r], C2, mnL); for (int r = 0; r < 16; ++r) p1[r] = fmaf(p1[r], C2, mnL);
    for (int r = 0; r < 16; ++r) p0[r] = __builtin_amdgcn_exp2f(p0[r]);
}
__device__ __forceinline__ void finishSM(f32x16& p0, f32x16& p1, float alpha, float& l_reg, bf16x8& pa0, bf16x8& pa1, bf16x8& pa2, bf16x8& pa3) {
    for (int r = 0; r < 16; ++r) p1[r] = __builtin_amdgcn_exp2f(p1[r]);
    float ps = 0; for (int r = 0; r < 16; ++r) ps += p0[r]; for (int r = 0; r < 16; ++r) ps += p1[r];
    { auto rr = __builtin_amdgcn_permlane32_swap(__float_as_uint(ps), __float_as_uint(ps), false, false);
      ps = __uint_as_float(rr[0]) + __uint_as_float(rr[1]); }
    l_reg = l_reg * alpha + ps;
#define PK4(P, B_, OUT) do { unsigned a0 = cvtpk(P[B_+0], P[B_+1]), a1 = cvtpk(P[B_+2], P[B_+3]);                          \
        unsigned b0 = cvtpk(P[B_+4], P[B_+5]), b1 = cvtpk(P[B_+6], P[B_+7]);                                             \
        auto r0 = __builtin_amdgcn_permlane32_swap(a0, b0, false, false); auto r1 = __builtin_amdgcn_permlane32_swap(a1, b1, false, false); \
        u32x4 w = {r0[0], r1[0], r0[1], r1[1]}; OUT = *reinterpret_cast<bf16x8*>(&w); } while (0)
    PK4(p0, 0, pa0); PK4(p0, 8, pa1); PK4(p1, 0, pa2); PK4(p1, 8, pa3);
#undef PK4
}
template <int KB, bool SK>
__device__ __forceinline__ void qkt(f32x16& p0, f32x16& p1, const char* K_lds, int r32, int hi, const bf16x8* qr, bool act) {
    if (SK && !act) { const float NEG = -__builtin_inff();
#pragma unroll
        for (int r = 0; r < 16; ++r) { p0[r] = NEG; p1[r] = NEG; } return; }
    p0 = f32x16{}; p1 = f32x16{};
    const char* kb[4];
#pragma unroll
    for (int dd = 0; dd < 4; ++dd) kb[dd] = K_lds + KB * SHM_K + KSWZ(r32, (dd * 16 + hi * 8) * 2);
#pragma unroll
    for (int d0 = 0; d0 < 8; ++d0) { const char* a = kb[d0 & 3] + (d0 >> 2) * 128;
        bf16x8 b0 = *reinterpret_cast<const bf16x8*>(a);
        bf16x8 b1 = *reinterpret_cast<const bf16x8*>(a + 32 * 256);
        p0 = __builtin_amdgcn_mfma_f32_32x32x16_bf16(b0, qr[d0], p0, 0, 0, 0);
        p1 = __builtin_amdgcn_mfma_f32_32x32x16_bf16(b1, qr[d0], p1, 0, 0, 0); }
}
template <int VB, bool SK>
__device__ __forceinline__ void pv_tile(f32x16* o, int vb0, bf16x8 pa0, bf16x8 pa1, bf16x8 pa2, bf16x8 pa3, bool act) {
    if (SK && !act) return;
#define TRRD(dst, off) asm volatile("ds_read_b64_tr_b16 %0, %1 offset:%2" : "=&v"(dst) : "v"(vb0), "i"(off) : "memory")
#define PV_D0(d0) do { s16x4 l0, l1, l2, l3, h0, h1, h2, h3; constexpr int b_ = VB * SHM_V + v_rd_off(d0, 0, 0);     \
        TRRD(l0, b_); TRRD(h0, b_ + 2048); TRRD(l1, b_ + 4096); TRRD(h1, b_ + 6144); TRRD(l2, b_ + 8192); TRRD(h2, b_ + 10240); TRRD(l3, b_ + 12288); TRRD(h3, b_ + 14336); \
        asm volatile("s_waitcnt lgkmcnt(0)" ::: "memory"); SBAR();                 \
        o[d0] = __builtin_amdgcn_mfma_f32_32x32x16_bf16(pa0, (bf16x8){l0[0], l0[1], l0[2], l0[3], h0[0], h0[1], h0[2], h0[3]}, o[d0], 0, 0, 0);   \
        o[d0] = __builtin_amdgcn_mfma_f32_32x32x16_bf16(pa1, (bf16x8){l1[0], l1[1], l1[2], l1[3], h1[0], h1[1], h1[2], h1[3]}, o[d0], 0, 0, 0);   \
        o[d0] = __builtin_amdgcn_mfma_f32_32x32x16_bf16(pa2, (bf16x8){l2[0], l2[1], l2[2], l2[3], h2[0], h2[1], h2[2], h2[3]}, o[d0], 0, 0, 0);   \
        o[d0] = __builtin_amdgcn_mfma_f32_32x32x16_bf16(pa3, (bf16x8){l3[0], l3[1], l3[2], l3[3], h3[0], h3[1], h3[2], h3[3]}, o[d0], 0, 0, 0); } while (0)
    PV_D0(0); PV_D0(1); PV_D0(2); PV_D0(3);
#undef PV_D0
#undef TRRD
}
#define VMW() asm volatile("s_waitcnt vmcnt(0)" ::: "memory")
#define VMWN(n) asm volatile("s_waitcnt vmcnt(%0)" :: "i"(n) : "memory")
template <int KB>
__device__ __forceinline__ void qkt_mla(f32x16& p0, f32x16& p1, const char* K_lds, const char* KR_lds, int r32, int hi, const bf16x8* qr) {
    p0 = f32x16{}; p1 = f32x16{};
    const char* kb[4];
#pragma unroll
    for (int dd = 0; dd < 4; ++dd) kb[dd] = K_lds + KB * SHM_K + KSWZ(r32, (dd * 16 + hi * 8) * 2);
#pragma unroll
    for (int d0 = 0; d0 < 8; ++d0) { const char* a = kb[d0 & 3] + (d0 >> 2) * 128;
        bf16x8 b0 = *reinterpret_cast<const bf16x8*>(a);
        bf16x8 b1 = *reinterpret_cast<const bf16x8*>(a + 32 * 256);
        p0 = __builtin_amdgcn_mfma_f32_32x32x16_bf16(b0, qr[d0], p0, 0, 0, 0);
        p1 = __builtin_amdgcn_mfma_f32_32x32x16_bf16(b1, qr[d0], p1, 0, 0, 0); }
    const char* kr = KR_lds + KB * SHM_KR + r32 * 144 + hi * 16;
#pragma unroll
    for (int d0 = 0; d0 < 4; ++d0) {
        bf16x8 b0 = *reinterpret_cast<const bf16x8*>(kr + d0 * 32);
        bf16x8 b1 = *reinterpret_cast<const bf16x8*>(kr + d0 * 32 + 32 * 144);
        p0 = __builtin_amdgcn_mfma_f32_32x32x16_bf16(b0, qr[8 + d0], p0, 0, 0, 0);
        p1 = __builtin_amdgcn_mfma_f32_32x32x16_bf16(b1, qr[8 + d0], p1, 0, 0, 0); }
}
struct MlaRef { const bf16* Q; const bf16* K; const bf16* KR; const bf16* V; bf16* O; int P0; };
constexpr int MLA_OS = 1024;
#define MROW(p, k0, rr) ((p) + (size_t)((k0) + (rr)) * D + sc)
#define MSLOAD(R_, k0) do { st_v0 = load8<bf16>(MROW((R_).V, k0, sr)); st_v1 = load8<bf16>(MROW((R_).V, k0, 32 + sr));              \
                         st_k0 = load8<bf16>(MROW((R_).K, k0, sr)); st_k1 = load8<bf16>(MROW((R_).K, k0, 32 + sr));                \
                         st_kr = load8<bf16>((R_).KR + (size_t)((k0) + (tid >> 3)) * 64 + (tid & 7) * 8); } while (0)
#define MSWRITE(bf) do { *(bf16x8*)(V_lds + (bf) * SHM_V + vst0) = st_v0; *(bf16x8*)(V_lds + (bf) * SHM_V + vst1) = st_v1;               \
                         *(bf16x8*)(K_lds + (bf) * SHM_K + kws) = st_k0; *(bf16x8*)(K_lds + (bf) * SHM_K + kws + 32 * 256) = st_k1;       \
                         *(bf16x8*)(KR_lds + (bf) * SHM_KR + krws) = st_kr; } while (0)
__device__ __forceinline__ void mla_block(const MlaRef& cur, char* lds) {
    int tid_ = threadIdx.x; asm volatile("" : "+v"(tid_));
    const int tid = tid_, wid = __builtin_amdgcn_readfirstlane(tid >> 6), lane = tid & 63, r32 = lane & 31, hi = lane >> 5;
    const int NT = (cur.P0 + QB) / KVBLK;
    const int qlo = cur.P0 + wid * QBLK, qm = qlo + r32 - 4 * hi;
    char* V_lds = lds; char* K_lds = lds + 2 * SHM_V; char* KR_lds = lds + 2 * SHM_V + 2 * SHM_K;
    float* ws = (float*)(lds + 2 * SHM_V + 2 * SHM_K + 2 * SHM_KR) + wid * 64; float* li_l = ws, * al_l = ws + 32;
    float m_reg = -1e30f, l_reg = 0; f32x16 o[4] = {};
    const int sr = tid >> 4, sc = (tid & 15) * 8, vst0 = v_st(sr, sc), vst1 = v_st(32 + sr, sc), kws = KSWZ(sr, sc * 2), krws = (tid >> 3) * 144 + (tid & 7) * 16;
    const int vb0 = (int)(uintptr_t)V_lds + v_rd_base(lane);
    bf16x8 qr[12]; bf16x8 st_v0, st_v1, st_k0, st_k1, st_kr;
#pragma unroll
    for (int d0 = 0; d0 < 12; ++d0) qr[d0] = load8<bf16>(cur.Q + (size_t)(wid * QBLK + r32) * 192 + d0 * 16 + hi * 8);
    MSLOAD(cur, 0); VMW(); MSWRITE(0);
    __syncthreads();
    for (int t = 0; t < NT; ++t) {
        const int buf = t & 1, kb = t * KVBLK;
        if (t + 1 < NT) MSLOAD(cur, kb + KVBLK);
        if (kb <= qlo + QBLK - 1) {
            f32x16 p0, p1; float mn, alpha; bf16x8 pa0, pa1, pa2, pa3;
            SBAR(); qkt_mla<0>(p0, p1, K_lds + buf * SHM_K, KR_lds + buf * SHM_KR, r32, hi, qr);
            if (kb + KVBLK - 1 > qlo) mask_tile(p0, p1, qm - kb, 1u << 30);
            partialSM(p0, p1, m_reg, mn, alpha);
            if (__any(alpha < 1.f)) { if (hi == 0) al_l[r32] = alpha; asm volatile("s_waitcnt lgkmcnt(0)" ::: "memory");
#pragma unroll
                for (int d_ = 0; d_ < 4; ++d_)
#pragma unroll
                    for (int r = 0; r < 16; ++r) o[d_][r] *= al_l[crow(r, hi)]; }
            finishSM(p0, p1, alpha, l_reg, pa0, pa1, pa2, pa3); SBAR();
            pv_tile<0, false>(o, vb0 + buf * SHM_V, pa0, pa1, pa2, pa3, true);
        }
        if (t + 1 < NT) { VMW(); MSWRITE(buf ^ 1); }
        __syncthreads();
    }
    if (hi == 0) li_l[r32] = l_reg; asm volatile("s_waitcnt lgkmcnt(0)" ::: "memory");
    float rli[16];
#pragma unroll
    for (int r = 0; r < 16; ++r) rli[r] = __builtin_amdgcn_rcpf(li_l[crow(r, hi)]);
    bf16* Ow = cur.O + (size_t)(wid * QBLK) * MLA_OS;
#pragma unroll
    for (int r = 0; r < 16; ++r) { const int orow = crow(r, hi);
#pragma unroll
        for (int d0 = 0; d0 < 4; ++d0) { const float v = o[d0][r] * rli[r];
            const float vn = __shfl_xor(v, 1);
            if ((r32 & 1) == 0) *(unsigned*)(Ow + (size_t)orow * MLA_OS + d0 * 32 + r32) = cvtpk(v, vn); } }
    __syncthreads();
}
#undef MROW
#undef MSLOAD
#undef MSWRITE
constexpr float SB_STOP = -170.f;
constexpr int SB_OS = 1024;
__device__ __forceinline__ void sb_block(const bf16* Qb, const bf16* Kh, const bf16* Vh, bf16* Ob, int q0, char* lds) {
    int tid_ = threadIdx.x; asm volatile("" : "+v"(tid_));
    const int tid = tid_, wid = __builtin_amdgcn_readfirstlane(tid >> 6), lane = tid & 63, r32 = lane & 31, hi = lane >> 5;
    char* V_lds = lds; char* K_lds = lds + 2 * SHM_V; volatile __attribute__((address_space(3))) int* flags = (volatile __attribute__((address_space(3))) int*)(lds + 2 * SHM_V + 2 * SHM_K);
    const int sr = tid >> 4, sc = (tid & 15) * 8, vst0 = v_st(sr, sc), vst1 = v_st(32 + sr, sc), kws = KSWZ(sr, sc * 2);
    const int vb0 = (int)(uintptr_t)V_lds + v_rd_base(lane);
    bf16x8 qr[8];
#pragma unroll
    for (int d0 = 0; d0 < 8; ++d0) qr[d0] = load8<bf16>(Qb + (size_t)(wid * QBLK + r32) * D + d0 * 16 + hi * 8);
    const int qlo = q0 + wid * QBLK, trow = qlo + r32;
    float R = 0.f; f32x16 o[4] = {};
    bool wdone = false;
    bf16x8 st_v0, st_v1, st_k0, st_k1;
#define SBLOAD(k0) do { st_v0 = load8<bf16>(Vh + (size_t)((k0) + sr) * D + sc); st_v1 = load8<bf16>(Vh + (size_t)((k0) + 32 + sr) * D + sc); \
                        st_k0 = load8<bf16>(Kh + (size_t)((k0) + sr) * D + sc); st_k1 = load8<bf16>(Kh + (size_t)((k0) + 32 + sr) * D + sc); } while (0)
    int j = q0 / KVBLK + 3;
    SBLOAD(j * KVBLK);
    for (int it = 0; ; ++it, --j) {
        const int buf = it & 1;
        VMW();
        *(bf16x8*)(V_lds + buf * SHM_V + vst0) = st_v0; *(bf16x8*)(V_lds + buf * SHM_V + vst1) = st_v1;
        *(bf16x8*)(K_lds + buf * SHM_K + kws) = st_k0; *(bf16x8*)(K_lds + buf * SHM_K + kws + 32 * 256) = st_k1;
        __syncthreads();
        if (it > 0) { int all = 1;
#pragma unroll
            for (int w = 0; w < 8; ++w) all &= flags[((it - 1) & 1) * 8 + w];
            if (__builtin_amdgcn_readfirstlane(all)) break; }
        if (j > 0) SBLOAD((j - 1) * KVBLK);
        const int kb = j * KVBLK;
        const bool act = !wdone && (kb < qlo + QBLK - 1);
        if (act) {
            f32x16 p0, p1, l0, l1;
            qkt<0, false>(p0, p1, K_lds + buf * SHM_K, r32, hi, qr, true);
            const int dq = trow - kb - 4 * hi;
#pragma unroll
            for (int r = 0; r < 16; ++r) { const int c = (r & 3) + 8 * (r >> 2);
                const float z0 = p0[r], z1 = p1[r];
                const float a0 = -(fmaxf(z0, 0.f) + __builtin_amdgcn_logf(1.f + __builtin_amdgcn_exp2f(-fabsf(z0))));
                const float a1 = -(fmaxf(z1, 0.f) + __builtin_amdgcn_logf(1.f + __builtin_amdgcn_exp2f(-fabsf(z1))));
                l0[r] = (c < dq) ? a0 : 0.f; l1[r] = (c + 32 < dq) ? a1 : 0.f; }
            float gs[8], ot[8], E[8];
#pragma unroll
            for (int k = 0; k < 4; ++k) { gs[k] = (l0[4 * k] + l0[4 * k + 1]) + (l0[4 * k + 2] + l0[4 * k + 3]); gs[4 + k] = (l1[4 * k] + l1[4 * k + 1]) + (l1[4 * k + 2] + l1[4 * k + 3]); }
#pragma unroll
            for (int k = 0; k < 8; ++k) { const unsigned gu = __float_as_uint(gs[k]); auto rr = __builtin_amdgcn_permlane32_swap(gu, gu, false, false); ot[k] = __uint_as_float(hi ? rr[0] : rr[1]); }
            float acc = 0.f;
#pragma unroll
            for (int k = 7; k >= 0; --k) { E[k] = acc + (hi == 0 ? ot[k] : 0.f); acc += gs[k] + ot[k]; }
#pragma unroll
            for (int k = 0; k < 4; ++k) {
                float s0 = E[k] + R, s1 = E[4 + k] + R;
#pragma unroll
                for (int q = 3; q >= 0; --q) { const int r = 4 * k + q, c = (r & 3) + 8 * (r >> 2);
                    s0 += l0[r]; s1 += l1[r];
                    const float w0 = __builtin_amdgcn_exp2f(p0[r] + s0), w1 = __builtin_amdgcn_exp2f(p1[r] + s1);
                    p0[r] = (c < dq) ? w0 : 0.f; p1[r] = (c + 32 < dq) ? w1 : 0.f; }
            }
            R += acc;
            bf16x8 pa0, pa1, pa2, pa3;
#define PK4(P, B_, OUT) do { unsigned a0 = cvtpk(P[B_+0], P[B_+1]), a1 = cvtpk(P[B_+2], P[B_+3]);                          \
        unsigned b0 = cvtpk(P[B_+4], P[B_+5]), b1 = cvtpk(P[B_+6], P[B_+7]);                                             \
        auto r0 = __builtin_amdgcn_permlane32_swap(a0, b0, false, false); auto r1 = __builtin_amdgcn_permlane32_swap(a1, b1, false, false); \
        u32x4 w = {r0[0], r1[0], r0[1], r1[1]}; OUT = *reinterpret_cast<bf16x8*>(&w); } while (0)
            PK4(p0, 0, pa0); PK4(p0, 8, pa1); PK4(p1, 0, pa2); PK4(p1, 8, pa3);
#undef PK4
            SBAR();
            pv_tile<0, false>(o, vb0 + buf * SHM_V, pa0, pa1, pa2, pa3, true);
            wdone = __all(R < SB_STOP);
        }
        if (lane == 0) flags[(it & 1) * 8 + wid] = wdone ? 1 : 0;
        if (j == 0) break;
    }
#undef SBLOAD
    bf16* Ow = Ob + (size_t)(wid * QBLK) * SB_OS;
#pragma unroll
    for (int r = 0; r < 16; ++r) { const int orow = crow(r, hi);
#pragma unroll
        for (int d0 = 0; d0 < 4; ++d0) { const float v = o[d0][r];
            const float vn = __shfl_xor(v, 1);
            if ((r32 & 1) == 0) *(unsigned*)(Ow + (size_t)orow * SB_OS + d0 * 32 + r32) = cvtpk(v, vn); } }
    __syncthreads();
}
}
template <int KIND> __device__ __forceinline__ int srcmap(int n) {
    if constexpr (KIND == 1) {
        if (n < 4096) return n;
        if (n < 4160) { const int j = n - 4096; return 4096 + (j & 1) * 32 + (j >> 1); }
        if (n < 4352) return -1;
        return n - 192;
    } else if constexpr (KIND == 2) {
        const int h = n / 192, dd = n - h * 192;
        if (dd < 128) return n;
        const int j = dd - 128; return h * 192 + 128 + (j & 1) * 32 + (j >> 1);
    } else return n;
}
template <int KIND> __device__ __forceinline__ void tr_item(const float* __restrict__ W, int K, int Nsrc, const float* __restrict__ gk, bf16_t* WT, LAS float* scr, int item, int nblk, int lane) {
    const int kb = item / nblk, nb = item - kb * nblk, k0 = 64 * kb, n0 = 32 * nb;
    const int src = srcmap<KIND>(n0 + (lane & 31));
#pragma unroll 8
    for (int i = 0; i < 32; ++i) { const int kk = 2 * i + (lane >> 5); float v = 0.f; if (src >= 0) v = __builtin_nontemporal_load(&W[(size_t)(k0 + kk) * Nsrc + src]); if (gk) v *= gk[k0 + kk]; scr[kk * 33 + (lane & 31)] = v; }
    asm volatile("s_waitcnt lgkmcnt(0)" ::: "memory");
    const int c = lane & 7;
#pragma unroll
    for (int j = 0; j < 4; ++j) { const int n = (lane >> 3) + 8 * j; const LAS float* s = scr + (8 * c) * 33 + n;
        u32x4 o; o.x = pk2(s[0 * 33], s[1 * 33]); o.y = pk2(s[2 * 33], s[3 * 33]); o.z = pk2(s[4 * 33], s[5 * 33]); o.w = pk2(s[6 * 33], s[7 * 33]);
        *(u32x4*)(WT + (size_t)(n0 + n) * K + k0 + 8 * c) = o; }
    asm volatile("s_waitcnt lgkmcnt(0)" ::: "memory");
}

#ifndef PHASE_MASK
#define PHASE_MASK 0xFFFF
#endif
struct Params { const float* in[20]; float* out; unsigned char* ws; };

__global__ void __launch_bounds__(512, 2) fwd(Params P) {
    extern __shared__ __attribute__((aligned(16))) unsigned char lds_raw[];
    LAS unsigned char* lds = (LAS unsigned char*)lds_raw;
    const int tid = threadIdx.x, lane = tid & 63, wave = __builtin_amdgcn_readfirstlane(tid >> 6);
    const int G = gridDim.x, bx = blockIdx.x;
    const int vcu = (G % 8 == 0) ? (bx % 8) * (G / 8) + bx / 8 : bx;
    const int gw = vcu * 8 + wave, NGW = G * 8;
#define CAS __attribute__((address_space(4)))
#define KARG(off) ({ const CAS char* k_ = (const CAS char*)__builtin_amdgcn_kernarg_segment_ptr(); asm volatile("" : "+s"(k_)); *(const CAS unsigned long long*)(k_ + (off)); })
#define GAS __attribute__((address_space(1)))
#define INP(i) ((const float*)(const GAS float*)KARG(8 * (i)))
#define OUT_P ((float*)(GAS float*)KARG(160))
#define WS_P ((unsigned char*)(GAS unsigned char*)KARG(168))
#define X_IN INP(0)
#define P_IN INP(1)
#define POS_IN ((const int*)INP(2))
#define ssq_cq ((float*)(WS_P + WS_SSQ))
#define ssq_ckv (ssq_cq + T_TOK)
#define ssq_y (ssq_cq + 2 * T_TOK)
#define ssq_d (ssq_cq + 3 * T_TOK)
#define ssq_e (ssq_cq + 4 * T_TOK)
#define wb ((bf16_t*)(WS_P + WS_W))
#define XN ((bf16_t*)(WS_P + WS_XN))
#define SBQ ((bf16_t*)(WS_P + WS_SBQ))
#define SBK ((bf16_t*)(WS_P + WS_SBK))
#define SBV ((bf16_t*)(WS_P + WS_SBV))
#define CQ ((bf16_t*)(WS_P + WS_CQ))
#define CKV ((bf16_t*)(WS_P + WS_CKV))
#define QMLA ((bf16_t*)(WS_P + WS_QMLA))
#define KN ((bf16_t*)(WS_P + WS_KN))
#define VMLA ((bf16_t*)(WS_P + WS_VMLA))
#define KROPE ((bf16_t*)(WS_P + WS_KROPE))
#define OSB ((bf16_t*)(WS_P + WS_OSB))
#define OMLA ((bf16_t*)(WS_P + WS_OMLA))
#define EB ((bf16_t*)(WS_P + WS_E))
#define MIXED ((bf16_t*)(WS_P + WS_MIXED))
#define YB ((bf16_t*)(WS_P + WS_Y))
#define PB ((bf16_t*)(WS_P + WS_PB))
#define UB ((bf16_t*)(WS_P + WS_U))
#define DN ((bf16_t*)(WS_P + WS_DN))
#define SGS ((bf16_t*)OUT_P)
#define SGM (SGS + (size_t)T_TOK * DM)
    { volatile LAS unsigned* st0 = (volatile LAS unsigned*)(lds + 131072 + 64); if (tid == 0) { st0[0] = 0u; st0[1] = 0u; } __syncthreads(); }
    cg::this_grid().sync();
    const XcdBarrier xbar = xcd_barrier_post((unsigned*)(WS_P + WS_BAR), (volatile LAS unsigned*)(lds + 131072 + 64));
#define GRID_SYNC() xcd_barrier(xbar)

    if (PHASE_MASK & (1 << 0)) {
        for (int i = (bx * 512 + tid); i < 5 * T_TOK; i += G * 512) ssq_cq[i] = 0.f;
        LAS float* scr = (LAS float*)(lds + wave * 16384);
        constexpr int I0 = (2048 / 64) * (NIN / 32), I1 = (512 / 64) * (1536 / 32), I2 = (512 / 64) * (2048 / 32), I3 = (1024 / 64) * (2048 / 32), I4 = I3,
                      I5 = (2048 / 64) * (2048 / 32), I6 = (2048 / 64) * (8192 / 32), I7 = (8192 / 64) * (2048 / 32), I8 = (256 / 64) * (2048 / 32), I9 = I5;
        constexpr int NITEMS = I0 + I1 + I2 + I3 + I4 + I5 + I6 + I7 + I8 + I9;
        for (int it = gw; it < NITEMS; it += NGW) {
            int r = it;
            if (r < I0) { tr_item<1>(INP(4), 2048, 8256, nullptr, wb + OFF_WIN, scr, r, NIN / 32, lane); continue; } r -= I0;
            if (r < I1) { tr_item<2>(INP(7), 512, 1536, INP(5), wb + OFF_WQ, scr, r, 1536 / 32, lane); continue; } r -= I1;
            if (r < I2) { tr_item<0>(INP(8), 512, 2048, INP(6), wb + OFF_WKV, scr, r, 2048 / 32, lane); continue; } r -= I2;
            if (r < I3) { tr_item<0>(INP(9), 1024, 2048, nullptr, wb + OFF_WSBO, scr, r, 2048 / 32, lane); continue; } r -= I3;
            if (r < I4) { tr_item<0>(INP(10), 1024, 2048, nullptr, wb + OFF_WMLAO, scr, r, 2048 / 32, lane); continue; } r -= I4;
            if (r < I5) { tr_item<0>(INP(11), 2048, 2048, nullptr, wb + OFF_WOUT, scr, r, 2048 / 32, lane); continue; } r -= I5;
            if (r < I6) { tr_item<0>(INP(14), 2048, 8192, nullptr, wb + OFF_WUP, scr, r, 8192 / 32, lane); continue; } r -= I6;
            if (r < I7) { tr_item<0>(INP(15), 8192, 2048, nullptr, wb + OFF_WDOWN, scr, r, 2048 / 32, lane); continue; } r -= I7;
            if (r < I8) { tr_item<0>(INP(17), 256, 2048, nullptr, wb + OFF_WPLE, scr, r, 2048 / 32, lane); continue; } r -= I8;
            tr_item<0>(INP(19), 2048, 2048, nullptr, wb + OFF_WPG, scr, r, 2048 / 32, lane);
        }
        const f32x4* gr = (const f32x4*)INP(3) + lane;
        for (int m = gw; m < T_TOK; m += NGW) {
            const f32x4* xr = (const f32x4*)(X_IN + (size_t)m * DM) + lane; f32x4 v[8]; float s = 0.f;
#pragma unroll
            for (int j = 0; j < 8; ++j) { v[j] = __builtin_nontemporal_load(&xr[64 * j]); s += (v[j].x * v[j].x + v[j].y * v[j].y) + (v[j].z * v[j].z + v[j].w * v[j].w); }
            const float rs = __builtin_amdgcn_rsqf(wave_sum(s) * (1.f / DM) + EPS);
            u32x2* o = (u32x2*)(XN + (size_t)m * DM) + lane;
#pragma unroll
            for (int j = 0; j < 8; ++j) { const f32x4 g = gr[64 * j]; u32x2 w; w.x = pk2(v[j].x * rs * g.x, v[j].y * rs * g.y); w.y = pk2(v[j].z * rs * g.z, v[j].w * rs * g.w); o[64 * j] = w; }
        }
    }
    GRID_SYNC();

    if (PHASE_MASK & (1 << 1)) {
        pg8::Gemm g{XN, wb + OFF_WIN, T_TOK, NIN, 2048}; pg8::StaticOrder S; S.init(T_TOK, NIN, G, bx);
        Epi<EK_P1> E{}; E.a.o0 = SBQ; E.a.o1 = SBK; E.a.o2 = SBV; E.a.o3 = CQ; E.a.o4 = CKV; E.a.o5 = KROPE; E.a.o6 = SGS; E.a.o7 = SGM; E.a.ssq0 = ssq_cq; E.a.ssq1 = ssq_ckv; E.a.pos = POS_IN;
        pg8::gemm_phase<Epi<EK_P1>, pg8::StaticOrder, true, true>(lds, g, S, E);
    }
    GRID_SYNC();

    if (PHASE_MASK & (1 << 2)) {
        { pg8::Gemm g{CQ, wb + OFF_WQ, T_TOK, 1536, 512}; pg8::StaticOrder S; S.init(T_TOK, 1536, G, bx);
          Epi<EK_Q> E{}; E.a.o0 = QMLA; E.a.ssq0 = ssq_cq; E.a.pos = POS_IN;
          pg8::gemm_phase<Epi<EK_Q>, pg8::StaticOrder, true, true>(lds, g, S, E); }
        { pg8::Gemm g{CKV, wb + OFF_WKV, T_TOK, 2048, 512}; pg8::StaticOrder S; S.init(T_TOK, 2048, G, bx);
          Epi<EK_KV> E{}; E.a.o0 = KN; E.a.o1 = VMLA; E.a.ssq0 = ssq_ckv;
          pg8::gemm_phase<Epi<EK_KV>, pg8::StaticOrder, true, true>(lds, g, S, E); }
    }
    GRID_SYNC();

    if (PHASE_MASK & (1 << 3)) {
        char* al = (char*)lds_raw;
#ifndef REP_SB
#define REP_SB 1
#endif
#ifndef NO_SB
        for (int rep_ = 0; rep_ < REP_SB; ++rep_)
        for (int L = vcu; L < 32 * 32; L += G) {
            const int bh = L >> 5, qb = L & 31, b = bh >> 3, h = bh & 7;
            att::sb_block((const att::bf16*)SBQ + ((size_t)bh * SEQ + qb * 256) * 128, (const att::bf16*)SBK + (size_t)bh * SEQ * 128, (const att::bf16*)SBV + (size_t)bh * SEQ * 128,
                          (att::bf16*)OSB + ((size_t)(b * SEQ + qb * 256)) * 1024 + h * 128, qb * 256, al);
        }
#endif
#ifndef NO_MLA
#ifndef REP_MLA
#define REP_MLA 1
#endif
        for (int rep_ = 0; rep_ < REP_MLA; ++rep_)
        for (int L = vcu; L < 32 * 16; L += G) {
            const int bh = L >> 4, xq = L & 15, b = bh >> 3, h = bh & 7;
#pragma unroll 1
            for (int pass = 0; pass < 2; ++pass) { const int qb = pass ? 31 - xq : xq;
                att::MlaRef r; r.Q = (const att::bf16*)QMLA + ((size_t)bh * SEQ + qb * 256) * 192; r.K = (const att::bf16*)KN + (size_t)bh * SEQ * 128;
                r.KR = (const att::bf16*)KROPE + (size_t)b * SEQ * 64; r.V = (const att::bf16*)VMLA + (size_t)bh * SEQ * 128;
                r.O = (att::bf16*)OMLA + ((size_t)(b * SEQ + qb * 256)) * 1024 + h * 128; r.P0 = qb * 256;
                att::mla_block(r, al); }
        }
#endif
    }
    GRID_SYNC();

    if (PHASE_MASK & (1 << 4)) {
        { pg8::Gemm g{OSB, wb + OFF_WSBO, T_TOK, 2048, 1024}; pg8::StaticOrder S; S.init(T_TOK, 2048, G, bx);
          Epi<EK_MIX1> E{}; E.a.o0 = MIXED; E.a.g0 = SGS;
          pg8::gemm_phase<Epi<EK_MIX1>, pg8::StaticOrder, true, true>(lds, g, S, E); }
        { pg8::Gemm g{OMLA, wb + OFF_WMLAO, T_TOK, 2048, 1024}; pg8::StaticOrder S; S.init(T_TOK, 2048, G, bx);
          Epi<EK_MIX2> E{}; E.a.o0 = MIXED; E.a.g0 = SGM;
          pg8::gemm_phase<Epi<EK_MIX2>, pg8::StaticOrder, true, true>(lds, g, S, E); }
    }
    GRID_SYNC();

    if (PHASE_MASK & (1 << 5)) {
        pg8::Gemm g{MIXED, wb + OFF_WOUT, T_TOK, 2048, 2048}; pg8::StaticOrder S; S.init(T_TOK, 2048, G, bx);
        Epi<EK_SSQ> E{}; E.a.o0 = YB; E.a.ssq0 = ssq_y;
        pg8::gemm_phase<Epi<EK_SSQ>, pg8::StaticOrder, true, true>(lds, g, S, E);
    }
    GRID_SYNC();

    if (PHASE_MASK & (1 << 6)) {
        const f32x4* g1 = (const f32x4*)INP(12) + lane; const f32x4* g2 = (const f32x4*)INP(13) + lane;
        for (int m = gw; m < T_TOK; m += NGW) {
            const float rsy = __builtin_amdgcn_rsqf(ssq_y[m] * (1.f / DM) + EPS);
            const f32x4* xr = (const f32x4*)(X_IN + (size_t)m * DM) + lane; const u32x2* yr = (const u32x2*)(YB + (size_t)m * DM) + lane;
            f32x4* orow = (f32x4*)(OUT_P + (size_t)m * DM) + lane;
            f32x4 v[8]; float s = 0.f;
#pragma unroll
            for (int j = 0; j < 8; ++j) { const f32x4 xv = __builtin_nontemporal_load(&xr[64 * j]); const u32x2 yw = __builtin_nontemporal_load(&yr[64 * j]); const f32x4 g = g1[64 * j];
                f32x4 t; t.x = xv.x + bf_lo(yw.x) * rsy * g.x; t.y = xv.y + bf_hi(yw.x) * rsy * g.y; t.z = xv.z + bf_lo(yw.y) * rsy * g.z; t.w = xv.w + bf_hi(yw.y) * rsy * g.w;
                v[j] = t; __builtin_nontemporal_store(t, &orow[64 * j]); s += (t.x * t.x + t.y * t.y) + (t.z * t.z + t.w * t.w); }
            const float rs = __builtin_amdgcn_rsqf(wave_sum(s) * (1.f / DM) + EPS);
            u32x2* o = (u32x2*)(XN + (size_t)m * DM) + lane;
#pragma unroll
            for (int j = 0; j < 8; ++j) { const f32x4 g = g2[64 * j]; u32x2 w; w.x = pk2(v[j].x * rs * g.x, v[j].y * rs * g.y); w.y = pk2(v[j].z * rs * g.z, v[j].w * rs * g.w); o[64 * j] = w; }
            const f32x4 pv = ((const f32x4*)(P_IN + (size_t)m * PLE))[lane]; u32x2 pw; pw.x = pk2(pv.x, pv.y); pw.y = pk2(pv.z, pv.w);
            ((u32x2*)(PB + (size_t)m * PLE))[lane] = pw;
        }
    }
    GRID_SYNC();

    if (PHASE_MASK & (1 << 7)) {
#ifndef REP_UP
#define REP_UP 1
#endif
        for (int rep_ = 0; rep_ < REP_UP; ++rep_)
        { pg8::Gemm g{XN, wb + OFF_WUP, T_TOK, FF, 2048}; pg8::StaticOrder S; S.init(T_TOK, FF, G, bx);
          Epi<EK_UP> E{}; E.a.o0 = UB;
          pg8::gemm_phase<Epi<EK_UP>, pg8::StaticOrder, true, true>(lds, g, S, E); }
        { pg8::Gemm g{PB, wb + OFF_WPLE, T_TOK, 2048, 256}; pg8::StaticOrder S; S.init(T_TOK, 2048, G, bx);
          Epi<EK_SSQ> E{}; E.a.o0 = EB; E.a.ssq0 = ssq_e;
          pg8::gemm_phase<Epi<EK_SSQ>, pg8::StaticOrder, true, true>(lds, g, S, E); }
    }
    GRID_SYNC();

    if (PHASE_MASK & (1 << 8)) {
        pg8::Gemm g{UB, wb + OFF_WDOWN, T_TOK, 2048, FF}; pg8::StaticOrder S; S.init(T_TOK, 2048, G, bx);
        Epi<EK_SSQ> E{}; E.a.o0 = DN; E.a.ssq0 = ssq_d;
        pg8::gemm_phase<Epi<EK_SSQ>, pg8::StaticOrder, true, true>(lds, g, S, E);
    }
    GRID_SYNC();

    if (PHASE_MASK & (1 << 9)) {
        const f32x4* g1 = (const f32x4*)INP(16) + lane;
        for (int m = gw; m < T_TOK; m += NGW) {
            const float rsd = __builtin_amdgcn_rsqf(ssq_d[m] * (1.f / DM) + EPS);
            const u32x2* dr = (const u32x2*)(DN + (size_t)m * DM) + lane;
            f32x4* orow = (f32x4*)(OUT_P + (size_t)m * DM) + lane; u32x2* o = (u32x2*)(XN + (size_t)m * DM) + lane;
#pragma unroll
            for (int j = 0; j < 8; ++j) { const f32x4 xv = __builtin_nontemporal_load(&orow[64 * j]); const u32x2 dw = __builtin_nontemporal_load(&dr[64 * j]); const f32x4 g = g1[64 * j];
                f32x4 t; t.x = xv.x + bf_lo(dw.x) * rsd * g.x; t.y = xv.y + bf_hi(dw.x) * rsd * g.y; t.z = xv.z + bf_lo(dw.y) * rsd * g.z; t.w = xv.w + bf_hi(dw.y) * rsd * g.w;
                orow[64 * j] = t; u32x2 w; w.x = pk2(t.x, t.y); w.y = pk2(t.z, t.w); o[64 * j] = w; }
        }
    }
    GRID_SYNC();

    if (PHASE_MASK & (1 << 10)) {
        pg8::Gemm g{XN, wb + OFF_WPG, T_TOK, 2048, 2048}; pg8::StaticOrder S; S.init(T_TOK, 2048, G, bx);
        Epi<EK_FIN> E{}; E.a.g0 = EB; E.a.ssq0 = ssq_e; E.a.outf = OUT_P; E.a.gv = INP(18);
        pg8::gemm_phase<Epi<EK_FIN>, pg8::StaticOrder, true, true>(lds, g, S, E);
    }
}

extern "C" void kernel_launch(void* const* d_in, const int* in_sizes, int n_in, void* d_out, int out_size, void* d_ws, size_t ws_size, hipStream_t stream) {
    static int grid_blocks = 0;
    if (grid_blocks == 0) {
        if (n_in != 20 || out_size != T_TOK * DM || ws_size < WS_END) { fprintf(stderr, "kernel_launch: unexpected shapes (n_in %d out %d ws %zu)\n", n_in, out_size, ws_size); grid_blocks = -1; return; }
        int dev = 0, cus = 0, per_cu = 0;
        (void)hipGetDevice(&dev); (void)hipDeviceGetAttribute(&cus, hipDeviceAttributeMultiprocessorCount, dev);
        (void)hipFuncSetAttribute((const void*)fwd, hipFuncAttributeMaxDynamicSharedMemorySize, LDS_BYTES);
        (void)hipOccupancyMaxActiveBlocksPerMultiprocessor(&per_cu, (const void*)fwd, 512, LDS_BYTES);
        if (per_cu < 1) { fprintf(stderr, "kernel_launch: occupancy query says %d blocks per CU\n", per_cu); per_cu = 1; }
        grid_blocks = cus * per_cu;
    }
    if (grid_blocks < 0) return;
    (void)hipMemsetAsync((char*)d_ws + WS_BAR, 0, 16384, stream);
    Params p{};
    for (int i = 0; i < 20; ++i) p.in[i] = (const float*)d_in[i];
    p.out = (float*)d_out; p.ws = (unsigned char*)d_ws;
    void* args[] = {&p};
    hipError_t e = hipLaunchCooperativeKernel((const void*)fwd, dim3(grid_blocks), dim3(512), args, LDS_BYTES, stream);
    if (e != hipSuccess) fprintf(stderr, "cooperative launch failed: %s (grid %d)\n", hipGetErrorString(e), grid_blocks);
}
```

```cpp
#include <hip/hip_runtime.h>
#include <hip/hip_bf16.h>
#include <hip/hip_cooperative_groups.h>
#include <cstdio>
#include <cstdint>
namespace cg = cooperative_groups;
namespace pg8 {
#define PG8_LAS __attribute__((address_space(3)))
typedef unsigned short bf16_t;
typedef short bf16x8 __attribute__((ext_vector_type(8)));
typedef float f32x4 __attribute__((ext_vector_type(4)));
typedef unsigned u32x4 __attribute__((ext_vector_type(4)));
constexpr int BM = 256, BK = 64, HALF = 128, HTB = HALF * BK * 2  , STAGE_BYTES = 8 * HTB, NXCD = 8, WGM = 4;

__host__ __device__ __forceinline__ int lds_byte(int r, int c) { const int st = (r >> 4) * 2 + (c >> 5), rr = r & 15, cc = c & 31, ob = rr * 64 + cc * 2; return st * 1024 + (ob ^ (((ob >> 9) & 1) << 5)); }
__host__ __device__ __forceinline__ void stage_rc(int b, int& R, int& C) { const int st = b / 1024, sb = b % 1024, swz = sb ^ (((sb >> 9) & 1) << 5); R = (st >> 1) * 16 + swz / 64; C = (st & 1) * 32 + (swz % 64) / 2; }
__host__ __device__ __forceinline__ int perm32(int rho) { const int n = rho >> 4, i = rho & 15; return 8 * (i >> 2) + 4 * n + (i & 3); }

struct Unit { int pm, pn; };
struct Gemm { const bf16_t* A; const bf16_t* Bt; int M, N, K; };
struct StaticOrder {
    int nM, nN, nwg, G, c;
    __host__ __device__ void init(int M, int N, int G_, int c_) { nM = M / BM; nN = N / BM; nwg = nM * nN; G = G_; c = c_; }
    __host__ __device__ bool next(int i, Unit& u) const {
        const long L = (long)i * G + c; if (L >= nwg) return false;
        int wgid = (int)L; { const int q = nwg / NXCD, r = nwg % NXCD, xcd = wgid % NXCD, off = wgid / NXCD; wgid = (xcd < r ? xcd * (q + 1) : r * (q + 1) + (xcd - r) * q) + off; }
        const int nig = WGM * nN, gid = wgid / nig, fm = gid * WGM, gsz = (nM - fm) < WGM ? (nM - fm) : WGM;
        u.pm = fm + ((wgid % nig) % gsz); u.pn = (wgid % nig) / gsz; return true;
    }
    __device__ __forceinline__ void a_ready(const Unit&) const {}
    __device__ __forceinline__ void done(const Unit&) const {}
};
typedef float f32x2_cv __attribute__((ext_vector_type(2))); typedef __bf16 bf16x2_cv __attribute__((ext_vector_type(2)));
__device__ __forceinline__ unsigned cvt_pk_bf16(float lo, float hi) { f32x2_cv v = {lo, hi}; bf16x2_cv b = __builtin_convertvector(v, bf16x2_cv); return __builtin_bit_cast(unsigned, b); }
typedef float f32x2 __attribute__((ext_vector_type(2)));
template <class Epi, class Sched, bool ALIGN_EPI = false, bool SP2 = false>
__device__ __forceinline__ void gemm_phase(PG8_LAS unsigned char* lds, const Gemm g, const Sched& S, const Epi& E) {
    int tid_ = threadIdx.x; asm volatile("" : "+v"(tid_));
    const int tid = tid_, wid = __builtin_amdgcn_readfirstlane(tid >> 6), lane = tid & 63, wr = wid >> 2, wc = wid & 3, fr = lane & 15, fq = lane >> 4;
    const int K = g.K, nt = K / BK;
    unsigned voffA[2], voffB[2];
#pragma unroll
    for (int i = 0; i < 2; ++i) { int R, C; stage_rc(tid * 16 + i * 8192, R, C); const int Rb = Epi::PERM ? ((R & ~31) + perm32(R & 31)) : R;
        voffA[i] = (unsigned)(R * K + C) * 2u; voffB[i] = (unsigned)(Rb * K + C) * 2u; }
    const size_t kstep = (size_t)(BK * 2);
    const size_t hstep = (size_t)HALF * K * 2;
    const size_t tstep = 2 * hstep;
    const unsigned ldsw = (unsigned)wid * 1024u;
    const int aoff = lds_byte(wr * 64 + fr, fq * 8), boff = lds_byte(wc * 32 + fr, fq * 8);
#define PG8_SA(b, h) (((b) * 2 + (h)) * HTB)
#define PG8_SB(b, h) ((4 + (b) * 2 + (h)) * HTB)
#define PG8_STAGE(bufoff, gbase, voff) do { _Pragma("unroll") for (int _i = 0; _i < 2; ++_i) \
        __builtin_amdgcn_global_load_lds((const unsigned*)((const char*)(gbase) + (voff)[_i]), (PG8_LAS unsigned*)(lds + (bufoff) + ldsw + _i * 8192), 16, 0, 0); } while (0)
#define PG8_LDA(dst, b, h) do { _Pragma("unroll") for (int m = 0; m < 4; ++m) _Pragma("unroll") for (int k = 0; k < 2; ++k) dst[m][k] = *(const PG8_LAS bf16x8*)(lds + PG8_SA(b, h) + aoff + m * 2048 + k * 1024); } while (0)
#define PG8_LDB(dst, b, h) do { _Pragma("unroll") for (int n = 0; n < 2; ++n) _Pragma("unroll") for (int k = 0; k < 2; ++k) dst[n][k] = *(const PG8_LAS bf16x8*)(lds + PG8_SB(b, h) + boff + n * 2048 + k * 1024); } while (0)
#define PG8_MMA(ai, bj, At, Bt) do { __builtin_amdgcn_s_setprio(1); _Pragma("unroll") for (int m = 0; m < 4; ++m) _Pragma("unroll") for (int n = 0; n < 2; ++n) _Pragma("unroll") for (int k = 0; k < 2; ++k) \
        acc[ai][bj][m][n] = __builtin_amdgcn_mfma_f32_16x16x32_bf16(Bt[n][k], At[m][k], acc[ai][bj][m][n], 0, 0, 0); __builtin_amdgcn_s_setprio(0); } while (0)
#define PG8_WAIT_V(n) asm volatile("s_waitcnt vmcnt(" #n ")" ::: "memory")
#define PG8_WAIT_L(n) asm volatile("s_waitcnt lgkmcnt(" #n ")" ::: "memory")
#define PG8_BAR __builtin_amdgcn_s_barrier()
#define PG8_SCHED __builtin_amdgcn_sched_barrier(0)
    Unit cur, nxt; int ui = 0;
    if (!S.next(0, cur)) return;
    f32x4 acc[2][2][4][2];
#pragma unroll
    for (int a = 0; a < 2; ++a)
#pragma unroll
        for (int b = 0; b < 2; ++b)
#pragma unroll
            for (int m = 0; m < 4; ++m)
#pragma unroll
                for (int n = 0; n < 2; ++n) acc[a][b][m][n] = (f32x4){0.f, 0.f, 0.f, 0.f};
    bf16x8 At[4][2], B0[2][2], B1[2][2];
    const char* cA = (const char*)g.A + (size_t)cur.pm * tstep; const char* cB = (const char*)g.Bt + (size_t)cur.pn * tstep;
    S.a_ready(cur);
    if constexpr (SP2) {
        PG8_STAGE(PG8_SB(0, 0), cB, voffB); PG8_STAGE(PG8_SB(0, 1), cB + hstep, voffB); PG8_STAGE(PG8_SA(0, 0), cA, voffA); PG8_STAGE(PG8_SA(0, 1), cA + hstep, voffA);
        if (wr == 1) PG8_BAR;
        PG8_WAIT_V(2); PG8_BAR;
        PG8_STAGE(PG8_SB(1, 0), cB + kstep, voffB); PG8_STAGE(PG8_SA(1, 0), cA + kstep, voffA); PG8_STAGE(PG8_SB(1, 1), cB + hstep + kstep, voffB);
        PG8_WAIT_V(6); PG8_BAR;
    } else {
        PG8_STAGE(PG8_SB(0, 0), cB, voffB); PG8_STAGE(PG8_SA(0, 0), cA, voffA); PG8_STAGE(PG8_SB(0, 1), cB + hstep, voffB); PG8_STAGE(PG8_SA(0, 1), cA + hstep, voffA);
        if (wr == 1) PG8_BAR;
        PG8_WAIT_V(4); PG8_BAR;
        PG8_STAGE(PG8_SB(1, 0), cB + kstep, voffB); PG8_STAGE(PG8_SA(1, 0), cA + kstep, voffA); PG8_STAGE(PG8_SB(1, 1), cB + hstep + kstep, voffB);
        PG8_WAIT_V(6); PG8_BAR;
    }
    for (;;) {
        const bool has_next = S.next(ui + 1, nxt);
        const char* nA = has_next ? (const char*)g.A + (size_t)nxt.pm * tstep : cA; const char* nB = has_next ? (const char*)g.Bt + (size_t)nxt.pn * tstep : cB;
        for (int t = 0; t < nt; t += 2) {
            const bool last = (t == nt - 2);
            const char* a1 = cA + (size_t)(t + 1) * kstep;
            const char* a2 = last ? nA : cA + (size_t)(t + 2) * kstep; const char* b2 = last ? nB : cB + (size_t)(t + 2) * kstep;
            const char* a3 = a2 + kstep; const char* b3 = b2 + kstep;
            if (last && has_next) S.a_ready(nxt);
            if constexpr (SP2) {
            PG8_LDB(B0, 0, 0); PG8_LDB(B1, 0, 1); PG8_SCHED; PG8_LDA(At, 0, 0); PG8_STAGE(PG8_SA(1, 1), a1 + hstep, voffA);
            PG8_WAIT_V(8); PG8_WAIT_L(0); PG8_BAR; PG8_MMA(0, 0, At, B0); PG8_MMA(0, 1, At, B1); PG8_BAR; PG8_SCHED;
            PG8_LDA(At, 0, 1); PG8_STAGE(PG8_SB(0, 0), b2, voffB); PG8_STAGE(PG8_SB(0, 1), b2 + hstep, voffB); PG8_STAGE(PG8_SA(0, 0), a2, voffA);
            PG8_WAIT_V(8); PG8_WAIT_L(0); PG8_BAR; PG8_MMA(1, 0, At, B0); PG8_MMA(1, 1, At, B1); PG8_BAR; PG8_SCHED;
            PG8_LDB(B0, 1, 0); PG8_LDB(B1, 1, 1); PG8_SCHED; PG8_LDA(At, 1, 0); PG8_STAGE(PG8_SA(0, 1), a2 + hstep, voffA);
            PG8_WAIT_V(8); PG8_WAIT_L(0); PG8_BAR; PG8_MMA(0, 0, At, B0); PG8_MMA(0, 1, At, B1); PG8_BAR; PG8_SCHED;
            PG8_LDA(At, 1, 1); PG8_STAGE(PG8_SB(1, 0), b3, voffB); PG8_STAGE(PG8_SB(1, 1), b3 + hstep, voffB); PG8_STAGE(PG8_SA(1, 0), a3, voffA);
            PG8_WAIT_V(8); PG8_WAIT_L(0); PG8_BAR; PG8_MMA(1, 0, At, B0); PG8_MMA(1, 1, At, B1); PG8_BAR; PG8_SCHED;
            } else {
            PG8_LDB(B0, 0, 0); PG8_SCHED; PG8_LDA(At, 0, 0); PG8_STAGE(PG8_SA(1, 1), a1 + hstep, voffA);
            PG8_WAIT_L(8); PG8_BAR; PG8_WAIT_L(0); PG8_MMA(0, 0, At, B0); PG8_BAR; PG8_SCHED;
            PG8_LDB(B1, 0, 1); PG8_STAGE(PG8_SB(0, 0), b2, voffB);
            PG8_BAR; PG8_WAIT_L(0); PG8_MMA(0, 1, At, B1); PG8_BAR;
            PG8_LDA(At, 0, 1); PG8_STAGE(PG8_SA(0, 0), a2, voffA);
            PG8_BAR; PG8_WAIT_L(0); PG8_MMA(1, 0, At, B0); PG8_BAR; PG8_SCHED;
            PG8_STAGE(PG8_SB(0, 1), b2 + hstep, voffB);
            PG8_WAIT_V(6); PG8_BAR; PG8_MMA(1, 1, At, B1); PG8_BAR;
            PG8_LDB(B0, 1, 0); PG8_SCHED; PG8_LDA(At, 1, 0); PG8_STAGE(PG8_SA(0, 1), a2 + hstep, voffA);
            PG8_WAIT_L(8); PG8_BAR; PG8_WAIT_L(0); PG8_MMA(0, 0, At, B0); PG8_BAR; PG8_SCHED;
            PG8_LDB(B1, 1, 1); PG8_STAGE(PG8_SB(1, 0), b3, voffB);
            PG8_BAR; PG8_WAIT_L(0); PG8_MMA(0, 1, At, B1); PG8_BAR;
            PG8_LDA(At, 1, 1); PG8_STAGE(PG8_SA(1, 0), a3, voffA);
            PG8_BAR; PG8_WAIT_L(0); PG8_MMA(1, 0, At, B0); PG8_BAR; PG8_SCHED;
            PG8_STAGE(PG8_SB(1, 1), b3 + hstep, voffB);
            PG8_WAIT_V(6); PG8_BAR; PG8_MMA(1, 1, At, B1); PG8_BAR;
            }
        }
        if constexpr (ALIGN_EPI) { if (wr == 0) PG8_BAR; }
        if constexpr (!Epi::AFTER_DRAIN) { E(acc, cur, wr, wc, fr, fq); S.done(cur); }
        if (!has_next) break;
#pragma unroll
        for (int a = 0; a < 2; ++a)
#pragma unroll
            for (int b = 0; b < 2; ++b)
#pragma unroll
                for (int m = 0; m < 4; ++m)
#pragma unroll
                    for (int n = 0; n < 2; ++n) acc[a][b][m][n] = (f32x4){0.f, 0.f, 0.f, 0.f};
        cur = nxt; cA = nA; cB = nB; ++ui;
        if constexpr (ALIGN_EPI) { if (wr == 1) PG8_BAR; }
    }
    PG8_WAIT_V(0);
    if constexpr (!ALIGN_EPI) { if (wr == 0) PG8_BAR; }
    PG8_BAR;
    if constexpr (Epi::AFTER_DRAIN) { E.fused(acc, cur, wr, wc, fr, fq, lds, wid, lane); S.done(cur); }
#undef PG8_SA
#undef PG8_SB
#undef PG8_STAGE
#undef PG8_LDA
#undef PG8_LDB
#undef PG8_MMA
#undef PG8_WAIT_V
#undef PG8_WAIT_L
#undef PG8_BAR
#undef PG8_SCHED
}
}
constexpr int T_TOK = 32768, SEQ = 8192, DM = 2048, NH = 8, FF = 8192, PLE = 256;
constexpr int NIN = 8448;
constexpr float EPS = 1e-6f;
constexpr float LOG2E = 1.4426950408889634f;
constexpr float SB_QSCALE = 0.08838834764831845f * LOG2E;
constexpr size_t MiB = 1u << 20;
constexpr size_t WS_BAR = 768 * 1024;
constexpr size_t WS_SSQ = 0;
constexpr size_t WS_W = 1 * MiB;
constexpr size_t OFF_WIN = 0, OFF_WQ = 17301504, OFF_WKV = 18087936, OFF_WSBO = 19136512, OFF_WMLAO = 21233664, OFF_WOUT = 23330816,
                 OFF_WUP = 27525120, OFF_WDOWN = 44302336, OFF_WPLE = 61079552, OFF_WPG = 61603840;
constexpr size_t WS_XN = 128 * MiB;
constexpr size_t WS_SBQ = 256 * MiB, WS_SBK = 320 * MiB, WS_SBV = 384 * MiB, WS_CQ = 448 * MiB, WS_CKV = 480 * MiB, WS_QMLA = 512 * MiB,
                 WS_KN = 608 * MiB, WS_VMLA = 672 * MiB, WS_KROPE = 736 * MiB, WS_OSB = 768 * MiB, WS_OMLA = 832 * MiB, WS_E = 896 * MiB;
constexpr size_t WS_MIXED = 256 * MiB, WS_Y = 384 * MiB, WS_PB = 768 * MiB, WS_U = 256 * MiB, WS_DN = 768 * MiB, WS_END = 1024 * MiB;
constexpr int LDS_BYTES = 132096;

typedef unsigned short bf16_t;
typedef float f32x4 __attribute__((ext_vector_type(4)));
typedef unsigned u32x4 __attribute__((ext_vector_type(4)));
typedef unsigned u32x2 __attribute__((ext_vector_type(2)));
#define LAS __attribute__((address_space(3)))

__device__ __forceinline__ unsigned pk2(float lo, float hi) { return pg8::cvt_pk_bf16(lo, hi); }
__device__ __forceinline__ float bf_lo(unsigned w) { return __uint_as_float(w << 16); }
__device__ __forceinline__ float bf_hi(unsigned w) { return __uint_as_float(w & 0xffff0000u); }
__device__ __forceinline__ void store8(bf16_t* dst, const float* v) { u32x4 w; w.x = pk2(v[0], v[1]); w.y = pk2(v[2], v[3]); w.z = pk2(v[4], v[5]); w.w = pk2(v[6], v[7]); *(u32x4*)dst = w; }
__device__ __forceinline__ void store8_nt(bf16_t* dst, const float* v) { u32x4 w; w.x = pk2(v[0], v[1]); w.y = pk2(v[2], v[3]); w.z = pk2(v[4], v[5]); w.w = pk2(v[6], v[7]); __builtin_nontemporal_store(w, (u32x4*)dst); }
__device__ __forceinline__ void load8(const bf16_t* src, float* v) { const u32x4 w = *(const u32x4*)src; v[0] = bf_lo(w.x); v[1] = bf_hi(w.x); v[2] = bf_lo(w.y); v[3] = bf_hi(w.y); v[4] = bf_lo(w.z); v[5] = bf_hi(w.z); v[6] = bf_lo(w.w); v[7] = bf_hi(w.w); }
__device__ __forceinline__ float sigmoidf_(float v) { return __builtin_amdgcn_rcpf(1.f + __builtin_amdgcn_exp2f(-v * LOG2E)); }
__device__ __forceinline__ float wave_sum(float v) {
#pragma unroll
    for (int o = 1; o < 64; o <<= 1) v += __shfl_xor(v, o);
    return v;
}
__device__ __forceinline__ void rope_pair(float& a, float& b, int pos, int i) {
    const float inv = __builtin_amdgcn_exp2f(-(float)i * 0.41524101186092029f);
    const float ang = (float)pos * inv;
    double rev = (double)ang * 0.15915494309189535;
    rev -= __builtin_rint(rev);
    const float fr = (float)rev;
    const float s = __builtin_amdgcn_sinf(fr), c = __builtin_amdgcn_cosf(fr);
    const float na = a * c - b * s, nb = a * s + b * c; a = na; b = nb;
}

struct EpiArgs {
    bf16_t* o0; bf16_t* o1; bf16_t* o2;
    bf16_t* o3; bf16_t* o4; bf16_t* o5; bf16_t* o6; bf16_t* o7;
    float* ssq0; float* ssq1;
    const bf16_t* g0; const bf16_t* g1;
    const int* pos; float* outf; const float* gv;
};
enum { EK_P1 = 0, EK_Q = 1, EK_KV = 2, EK_MIX1 = 3, EK_MIX2 = 4, EK_SSQ = 5, EK_UP = 6, EK_FIN = 7 };
template <int KIND> struct Epi {
    static constexpr bool PERM = true, AFTER_DRAIN = false;
    EpiArgs a;
    __device__ __forceinline__ void operator()(const pg8::f32x4 (&acc)[2][2][4][2], const pg8::Unit& u, int wr, int wc, int fr, int fq) const {
        const int pn = u.pn;
#pragma unroll
        for (int ai = 0; ai < 2; ++ai)
#pragma unroll
            for (int m = 0; m < 4; ++m) {
                const int row = u.pm * 256 + ai * 128 + wr * 64 + m * 16 + fr;
                const int bb = row >> 13, ss = row & 8191;
                float ssq = 0.f;
                float rs = 1.f;
                if constexpr (KIND == EK_Q || KIND == EK_KV) rs = __builtin_amdgcn_rsqf(a.ssq0[row] * (1.f / 512.f) + EPS);
                if constexpr (KIND == EK_FIN) rs = __builtin_amdgcn_rsqf(a.ssq0[row] * (1.f / 2048.f) + EPS);
#pragma unroll
                for (int bj = 0; bj < 2; ++bj) {
                    const int cl = bj * 128 + wc * 32 + fq * 8;
                    float v[8];
#pragma unroll
                    for (int j = 0; j < 4; ++j) { v[j] = acc[ai][bj][m][0][j]; v[4 + j] = acc[ai][bj][m][1][j]; }
                    if constexpr (KIND == EK_P1) {
                        if (pn < 12) {
                            const int t = pn >> 2, c = (pn & 3) * 256 + cl, h = c >> 7, d = c & 127;
                            if (t == 0) {
#pragma unroll
                                for (int j = 0; j < 8; ++j) v[j] *= SB_QSCALE;
                            }
                            bf16_t* base = t == 0 ? a.o0 : (t == 1 ? a.o1 : a.o2);
                            store8(base + ((size_t)((bb * NH + h) * SEQ + ss)) * 128 + d, v);
                        } else if (pn < 16) {
                            const int t = (pn - 12) >> 1, c = ((pn - 12) & 1) * 256 + cl;
#pragma unroll
                            for (int j = 0; j < 8; ++j) ssq += v[j] * v[j];
                            store8((t ? a.o4 : a.o3) + (size_t)row * 512 + c, v);
                        } else if (pn == 16) {
                            if (cl < 64) {
                                const int p = a.pos[row];
#pragma unroll
                                for (int j = 0; j < 4; ++j) rope_pair(v[2 * j], v[2 * j + 1], p, (cl >> 1) + j);
                                store8(a.o5 + (size_t)row * 64 + cl, v);
                            }
                        } else {
                            const int t = (pn - 17) >> 3, c = ((pn - 17) & 7) * 256 + cl;
#pragma unroll
                            for (int j = 0; j < 8; ++j) v[j] = sigmoidf_(v[j]);
                            store8_nt((t ? a.o7 : a.o6) + (size_t)row * 2048 + c, v);
                        }
                    } else if constexpr (KIND == EK_Q) {
                        const int c = pn * 256 + cl, h = c / 192, dd = c - h * 192;
#pragma unroll
                        for (int j = 0; j < 8; ++j) v[j] *= rs;
                        if (dd >= 128) {
                            const int p = a.pos[row];
#pragma unroll
                            for (int j = 0; j < 4; ++j) rope_pair(v[2 * j], v[2 * j + 1], p, ((dd - 128) >> 1) + j);
                        }
                        store8(a.o0 + ((size_t)((bb * NH + h) * SEQ + ss)) * 192 + dd, v);
                    } else if constexpr (KIND == EK_KV) {
#pragma unroll
                        for (int j = 0; j < 8; ++j) v[j] *= rs;
                        store8((bj ? a.o1 : a.o0) + ((size_t)((bb * NH + pn) * SEQ + ss)) * 128 + (cl & 127), v);
                    } else if constexpr (KIND == EK_MIX1) {
                        const size_t off = (size_t)row * 2048 + pn * 256 + cl; float g[8]; load8(a.g0 + off, g);
#pragma unroll
                        for (int j = 0; j < 8; ++j) v[j] *= g[j];
                        store8(a.o0 + off, v);
                    } else if constexpr (KIND == EK_MIX2) {
                        const size_t off = (size_t)row * 2048 + pn * 256 + cl; float g[8], pr[8]; load8(a.g0 + off, g); load8(a.o0 + off, pr);
#pragma unroll
                        for (int j = 0; j < 8; ++j) v[j] = pr[j] + v[j] * g[j];
                        store8(a.o0 + off, v);
                    } else if constexpr (KIND == EK_SSQ) {
#pragma unroll
                        for (int j = 0; j < 8; ++j) ssq += v[j] * v[j];
                        store8(a.o0 + (size_t)row * 2048 + pn * 256 + cl, v);
                    } else if constexpr (KIND == EK_UP) {
#pragma unroll
                        for (int j = 0; j < 8; ++j) { const float r = fmaxf(v[j], 0.f); v[j] = r * r; }
                        { u32x4 w; w.x = pk2(v[0], v[1]); w.y = pk2(v[2], v[3]); w.z = pk2(v[4], v[5]); w.w = pk2(v[6], v[7]); __builtin_nontemporal_store(w, (u32x4*)(a.o0 + (size_t)row * FF + pn * 256 + cl)); }
                    } else if constexpr (KIND == EK_FIN) {
                        const int c = pn * 256 + cl; const size_t off = (size_t)row * 2048 + c; float e[8]; load8(a.g0 + off, e);
                        const f32x4 x0 = *(const f32x4*)(a.outf + off), x1 = *(const f32x4*)(a.outf + off + 4);
                        const f32x4 g0 = *(const f32x4*)(a.gv + c), g1 = *(const f32x4*)(a.gv + c + 4);
                        f32x4 r0, r1;
#pragma unroll
                        for (int j = 0; j < 4; ++j) { r0[j] = x0[j] + sigmoidf_(v[j]) * (e[j] * rs * g0[j]); r1[j] = x1[j] + sigmoidf_(v[4 + j]) * (e[4 + j] * rs * g1[j]); }
                        *(f32x4*)(a.outf + off) = r0; *(f32x4*)(a.outf + off + 4) = r1;
                    }
                }
                if constexpr (KIND == EK_P1) {
                    if (pn >= 12 && pn < 16) { ssq += __shfl_xor(ssq, 16); ssq += __shfl_xor(ssq, 32); if (fq == 0) atomicAdd((pn >= 14 ? a.ssq1 : a.ssq0) + row, ssq); }
                }
                if constexpr (KIND == EK_SSQ) { ssq += __shfl_xor(ssq, 16); ssq += __shfl_xor(ssq, 32); if (fq == 0) atomicAdd(a.ssq0 + row, ssq); }
            }
    }
};
#define XB_TMO      128
#define XB_XCNT(j)  (256  + 64 * (j))
#define XB_XSUB(j)  (1280 + 64 * (j))
#define XB_XGEN(j)  (2304 + 64 * (j))
#define XB_TOP      3328
#define XB_TOPGEN   3392
#define XCD_BAR_WORDS 3456
#define XB_SPIN_CAP (1u << 18)

__device__ __forceinline__ unsigned xb_ld(unsigned* p)              { return __hip_atomic_load(p, __ATOMIC_RELAXED, __HIP_MEMORY_SCOPE_AGENT); }
__device__ __forceinline__ unsigned xb_add(unsigned* p, unsigned v) { return __hip_atomic_fetch_add(p, v, __ATOMIC_RELAXED, __HIP_MEMORY_SCOPE_AGENT); }
__device__ __forceinline__ unsigned xb_xcc_id() { return (unsigned)__builtin_amdgcn_s_getreg((3 << 11) | 20) & 0xFu; }
#define XB_SPIN(cond, bar) do { unsigned _sp = 0; while (cond) { __builtin_amdgcn_s_sleep(1); \
    if ((++_sp & 255u) == 0u) { if (xb_ld(&(bar)[XB_TMO])) break; if (_sp > XB_SPIN_CAP) { atomicAdd(&(bar)[XB_TMO], 1u); break; } } } } while (0)

struct XcdBarrier {
    unsigned* bar; unsigned x;
    volatile LAS unsigned* st;
};

__device__ __forceinline__ XcdBarrier xcd_barrier_post(unsigned* bar, volatile LAS unsigned* st) {
    XcdBarrier b; b.bar = bar; b.x = xb_xcc_id(); b.st = st;
    if (threadIdx.x == 0) (void)xb_add(&bar[XB_XCNT(b.x)], 1u);
    return b;
}
__device__ __forceinline__ void xcd_barrier_complete(unsigned* bar, unsigned x, unsigned& nloc, unsigned& nx) {
    const unsigned G = gridDim.x * gridDim.y * gridDim.z;
    unsigned sum, cnt, mine, sp = 0u;
    for (;;) {
        sum = 0u; cnt = 0u; mine = 0u;
#pragma unroll
        for (unsigned j = 0; j < 16; ++j) { const unsigned c = xb_ld(&bar[XB_XCNT(j)]); sum += c; cnt += (c > 0u) ? 1u : 0u; mine = (j == x) ? c : mine; }
        if (sum == G) break;
        __builtin_amdgcn_s_sleep(1);
        if ((++sp & 255u) == 0u) { if (xb_ld(&bar[XB_TMO])) break; if (sp > XB_SPIN_CAP) { atomicAdd(&bar[XB_TMO], 1u); break; } }
    }
    nloc = mine > 0u ? mine : 1u; nx = cnt > 0u ? cnt : 1u;
}

__device__ __forceinline__ void xcd_barrier(const XcdBarrier& b) {
    asm volatile("s_waitcnt vmcnt(0)" ::: "memory");
    __syncthreads();
    if (threadIdx.x == 0) {
        unsigned* bar = b.bar;
        __builtin_amdgcn_s_waitcnt(0);
        unsigned nloc = b.st[0], nx = b.st[1];
        if (nloc == 0u) { xcd_barrier_complete(bar, b.x, nloc, nx); b.st[0] = nloc; b.st[1] = nx; }
        const unsigned old = xb_add(&bar[XB_XSUB(b.x)], 1u);
        const unsigned gen = old / nloc;
        if (old + 1u == (gen + 1u) * nloc) {
            __builtin_amdgcn_fence(__ATOMIC_RELEASE, "agent");
            asm volatile("s_waitcnt vmcnt(0)" ::: "memory");
            const unsigned og = xb_add(&bar[XB_TOP], 1u);
            const unsigned tg = og / nx;
            if (og + 1u == (tg + 1u) * nx) xb_add(&bar[XB_TOPGEN], 1u);
            else XB_SPIN(xb_ld(&bar[XB_TOPGEN]) == tg, bar);
            __builtin_amdgcn_fence(__ATOMIC_ACQUIRE, "agent");
            xb_add(&bar[XB_XGEN(b.x)], 1u);
            asm volatile("s_waitcnt vmcnt(0)" ::: "memory");
        } else {
            XB_SPIN(xb_ld(&bar[XB_XGEN(b.x)]) == gen, bar);
            __builtin_amdgcn_fence(__ATOMIC_ACQUIRE, "agent");
            asm volatile("s_waitcnt vmcnt(0)" ::: "memory");
        }
    }
    __syncthreads();
}
namespace att {
using bf16 = __hip_bfloat16;
typedef short bf16x8 __attribute__((ext_vector_type(8)));
typedef short s16x4 __attribute__((ext_vector_type(4)));
typedef float f32x16 __attribute__((ext_vector_type(16)));
typedef float f32x4 __attribute__((ext_vector_type(4)));
typedef unsigned u32x4 __attribute__((ext_vector_type(4)));
template <class A, class Bt> struct same_t { static constexpr bool v = false; };
template <class A> struct same_t<A, A> { static constexpr bool v = true; };
constexpr int D = 128, NW = 8, QBLK = 32, KVBLK = 64, QB = NW * QBLK;
constexpr int SHM_V = KVBLK * D * 2, SHM_K = KVBLK * D * 2, SHM_KR = 64 * 144;
constexpr float SCALE = 0.07216878364870323f;
constexpr float THR = 8.f;
constexpr bool WSKIP = false;
#define KSWZ(row, colB) ((row) * 256 + ((colB) ^ (((row) & 7) << 4)))
#define SBAR() __builtin_amdgcn_sched_barrier(0)
__device__ __forceinline__ int v_st(int k, int c) { const int kk = (k & ~0xC) | ((k & 4) << 1) | ((k & 8) >> 1); return ((kk >> 3) * 4 + (c >> 5)) * 512 + ((kk & 7) * 32 + (c & 31)) * 2; }
__device__ __forceinline__ int v_rd_base(int lane) { return ((lane & 3) << 3) | (((lane >> 2) & 3) << 6) | (((lane >> 4) & 1) << 5) | (((lane >> 5) & 1) << 8); }
constexpr int v_rd_off(int d0, int ks, int half) { return d0 * 512 + ks * 4096 + half * 2048; }
__device__ __forceinline__ int crow(int r, int hi) { return (r & 3) + 8 * (r >> 2) + 4 * hi; }
__device__ __forceinline__ unsigned cvtpk(float lo, float hi) {
    typedef float f32x2_cv __attribute__((ext_vector_type(2))); typedef __bf16 bf16x2_cv __attribute__((ext_vector_type(2)));
    f32x2_cv v = {lo, hi}; bf16x2_cv b = __builtin_convertvector(v, bf16x2_cv); return __builtin_bit_cast(unsigned, b);
}
__device__ __forceinline__ bf16x8 pack8(f32x4 a, f32x4 b) {
    u32x4 w = {cvtpk(a[0], a[1]), cvtpk(a[2], a[3]), cvtpk(b[0], b[1]), cvtpk(b[2], b[3])};
    return *reinterpret_cast<bf16x8*>(&w);
}
template <class T> __device__ __forceinline__ bf16x8 load8(const T* p) {
    if constexpr (same_t<T, float>::v) { return pack8(*(const f32x4*)p, *(const f32x4*)(p + 4)); }
    else { return *reinterpret_cast<const bf16x8*>(p); }
}
__device__ __forceinline__ void mask_tile(f32x16& p0, f32x16& p1, int dq, unsigned W) {
    const float NEG = -__builtin_inff();
#pragma unroll
    for (int r = 0; r < 16; ++r) {
        const int c = (r & 3) + 8 * (r >> 2);
        if ((unsigned)(dq - c) >= W) p0[r] = NEG;
        if ((unsigned)(dq - c - 32) >= W) p1[r] = NEG;
    }
}
__device__ __forceinline__ void partialSM(f32x16& p0, f32x16& p1, float& m_reg, float& mn, float& alpha) {
    float pmax = p0[0]; for (int r = 1; r < 16; ++r) pmax = fmaxf(pmax, p0[r]); for (int r = 0; r < 16; ++r) pmax = fmaxf(pmax, p1[r]);
    { auto rr = __builtin_amdgcn_permlane32_swap(__float_as_uint(pmax), __float_as_uint(pmax), false, false);
      pmax = fmaxf(__uint_as_float(rr[0]), __uint_as_float(rr[1])); }
    constexpr float C2 = 1.4426950408889634f * SCALE;
    if (__builtin_expect(__all((pmax - m_reg) * SCALE <= THR), 1)) { mn = m_reg; alpha = 1.f; }
    else { mn = fmaxf(m_reg, pmax); alpha = __builtin_amdgcn_exp2f((m_reg - mn) * C2); m_reg = mn; }
    const float mnL = -mn * C2;
    for (int r = 0; r < 16; ++r) p0[r] = fmaf(p0[r], C2, mnL); for (int r = 0; r < 16; ++r) p1[r] = fmaf(p1[r], C2, mnL);
    for (int r = 0; r < 16; ++r) p0[r] = __builtin_amdgcn_exp2f(p0[r]);
}
__device__ __forceinline__ void finishSM(f32x16& p0, f32x16& p1, float alpha, float& l_reg, bf16x8& pa0, bf16x8& pa1, bf16x8& pa2, bf16x8& pa3) {
    for (int r = 0; r < 16; ++r) p1[r] = __builtin_amdgcn_exp2f(p1[r]);
    float ps = 0; for (int r = 0; r < 16; ++r) ps += p0[r]; for (int r = 0; r < 16; ++r) ps += p1[r];
    { auto rr = __builtin_amdgcn_permlane32_swap(__float_as_uint(ps), __float_as_uint(ps), false, false);
      ps = __uint_as_float(rr[0]) + __uint_as_float(rr[1]); }
    l_reg = l_reg * alpha + ps;
#define PK4(P, B_, OUT) do { unsigned a0 = cvtpk(P[B_+0], P[B_+1]), a1 = cvtpk(P[B_+2], P[B_+3]);                          \
        unsigned b0 = cvtpk(P[B_+4], P[B_+5]), b1 = cvtpk(P[B_+6], P[B_+7]);                                             \
        auto r0 = __builtin_amdgcn_permlane32_swap(a0, b0, false, false); auto r1 = __builtin_amdgcn_permlane32_swap(a1, b1, false, false); \
        u32x4 w = {r0[0], r1[0], r0[1], r1[1]}; OUT = *reinterpret_cast<bf16x8*>(&w); } while (0)
    PK4(p0, 0, pa0); PK4(p0, 8, pa1); PK4(p1, 0, pa2); PK4(p1, 8, pa3);
#undef PK4
}
template <int KB, bool SK>
__device__ __forceinline__ void qkt(f32x16& p0, f32x16& p1, const char* K_lds, int r32, int hi, const bf16x8* qr, bool act) {
    if (SK && !act) { const float NEG = -__builtin_inff();
#pragma unroll
        for (int r = 0; r < 16; ++r) { p0[r] = NEG; p1[r] = NEG; } return; }
    p0 = f32x16{}; p1 = f32x16{};
    const char* kb[4];
#pragma unroll
    for (int dd = 0; dd < 4; ++dd) kb[dd] = K_lds + KB * SHM_K + KSWZ(r32, (dd * 16 + hi * 8) * 2);
#pragma unroll
    for (int d0 = 0; d0 < 8; ++d0) { const char* a = kb[d0 & 3] + (d0 >> 2) * 128;
        bf16x8 b0 = *reinterpret_cast<const bf16x8*>(a);
        bf16x8 b1 = *reinterpret_cast<const bf16x8*>(a + 32 * 256);
        p0 = __builtin_amdgcn_mfma_f32_32x32x16_bf16(b0, qr[d0], p0, 0, 0, 0);
        p1 = __builtin_amdgcn_mfma_f32_32x32x16_bf16(b1, qr[d0], p1, 0, 0, 0); }
}
template <int VB, bool SK>
__device__ __forceinline__ void pv_tile(f32x16* o, int vb0, bf16x8 pa0, bf16x8 pa1, bf16x8 pa2, bf16x8 pa3, bool act) {
    if (SK && !act) return;
#define TRRD(dst, off) asm volatile("ds_read_b64_tr_b16 %0, %1 offset:%2" : "=&v"(dst) : "v"(vb0), "i"(off) : "memory")
#define PV_D0(d0) do { s16x4 l0, l1, l2, l3, h0, h1, h2, h3; constexpr int b_ = VB * SHM_V + v_rd_off(d0, 0, 0);     \
        TRRD(l0, b_); TRRD(h0, b_ + 2048); TRRD(l1, b_ + 4096); TRRD(h1, b_ + 6144); TRRD(l2, b_ + 8192); TRRD(h2, b_ + 10240); TRRD(l3, b_ + 12288); TRRD(h3, b_ + 14336); \
        asm volatile("s_waitcnt lgkmcnt(0)" ::: "memory"); SBAR();                 \
        o[d0] = __builtin_amdgcn_mfma_f32_32x32x16_bf16(pa0, (bf16x8){l0[0], l0[1], l0[2], l0[3], h0[0], h0[1], h0[2], h0[3]}, o[d0], 0, 0, 0);   \
        o[d0] = __builtin_amdgcn_mfma_f32_32x32x16_bf16(pa1, (bf16x8){l1[0], l1[1], l1[2], l1[3], h1[0], h1[1], h1[2], h1[3]}, o[d0], 0, 0, 0);   \
        o[d0] = __builtin_amdgcn_mfma_f32_32x32x16_bf16(pa2, (bf16x8){l2[0], l2[1], l2[2], l2[3], h2[0], h2[1], h2[2], h2[3]}, o[d0], 0, 0, 0);   \
        o[d0] = __builtin_amdgcn_mfma_f32_32x32x16_bf16(pa3, (bf16x8){l3[0], l3[1], l3[2], l3[3], h3[0], h3[1], h3[2], h3[3]}, o[d0], 0, 0, 0); } while (0)
    PV_D0(0); PV_D0(1); PV_D0(2); PV_D0(3);
#undef PV_D0
#undef TRRD
}
#define VMW() asm volatile("s_waitcnt vmcnt(0)" ::: "memory")
#define VMWN(n) asm volatile("s_waitcnt vmcnt(%0)" :: "i"(n) : "memory")
template <int KB>
__device__ __forceinline__ void qkt_mla(f32x16& p0, f32x16& p1, const char* K_lds, const char* KR_lds, int r32, int hi, const bf16x8* qr) {
    p0 = f32x16{}; p1 = f32x16{};
    const char* kb[4];
#pragma unroll
    for (int dd = 0; dd < 4; ++dd) kb[dd] = K_lds + KB * SHM_K + KSWZ(r32, (dd * 16 + hi * 8) * 2);
#pragma unroll
    for (int d0 = 0; d0 < 8; ++d0) { const char* a = kb[d0 & 3] + (d0 >> 2) * 128;
        bf16x8 b0 = *reinterpret_cast<const bf16x8*>(a);
        bf16x8 b1 = *reinterpret_cast<const bf16x8*>(a + 32 * 256);
        p0 = __builtin_amdgcn_mfma_f32_32x32x16_bf16(b0, qr[d0], p0, 0, 0, 0);
        p1 = __builtin_amdgcn_mfma_f32_32x32x16_bf16(b1, qr[d0], p1, 0, 0, 0); }
    const char* kr = KR_lds + KB * SHM_KR + r32 * 144 + hi * 16;
#pragma unroll
    for (int d0 = 0; d0 < 4; ++d0) {
        bf16x8 b0 = *reinterpret_cast<const bf16x8*>(kr + d0 * 32);
        bf16x8 b1 = *reinterpret_cast<const bf16x8*>(kr + d0 * 32 + 32 * 144);
        p0 = __builtin_amdgcn_mfma_f32_32x32x16_bf16(b0, qr[8 + d0], p0, 0, 0, 0);
        p1 = __builtin_amdgcn_mfma_f32_32x32x16_bf16(b1, qr[8 + d0], p1, 0, 0, 0); }
}
struct MlaRef { const bf16* Q; const bf16* K; const bf16* KR; const bf16* V; bf16* O; int P0; };
constexpr int MLA_OS = 1024;
#define MROW(p, k0, rr) ((p) + (size_t)((k0) + (rr)) * D + sc)
#define MSLOAD(R_, k0) do { st_v0 = load8<bf16>(MROW((R_).V, k0, sr)); st_v1 = load8<bf16>(MROW((R_).V, k0, 32 + sr));              \
                         st_k0 = load8<bf16>(MROW((R_).K, k0, sr)); st_k1 = load8<bf16>(MROW((R_).K, k0, 32 + sr));                \
                         st_kr = load8<bf16>((R_).KR + (size_t)((k0) + (tid >> 3)) * 64 + (tid & 7) * 8); } while (0)
#define MSWRITE(bf) do { *(bf16x8*)(V_lds + (bf) * SHM_V + vst0) = st_v0; *(bf16x8*)(V_lds + (bf) * SHM_V + vst1) = st_v1;               \
                         *(bf16x8*)(K_lds + (bf) * SHM_K + kws) = st_k0; *(bf16x8*)(K_lds + (bf) * SHM_K + kws + 32 * 256) = st_k1;       \
                         *(bf16x8*)(KR_lds + (bf) * SHM_KR + krws) = st_kr; } while (0)
__device__ __forceinline__ void mla_block(const MlaRef& cur, char* lds) {
    int tid_ = threadIdx.x; asm volatile("" : "+v"(tid_));
    const int tid = tid_, wid = __builtin_amdgcn_readfirstlane(tid >> 6), lane = tid & 63, r32 = lane & 31, hi = lane >> 5;
    const int NT = (cur.P0 + QB) / KVBLK;
    const int qlo = cur.P0 + wid * QBLK, qm = qlo + r32 - 4 * hi;
    char* V_lds = lds; char* K_lds = lds + 2 * SHM_V; char* KR_lds = lds + 2 * SHM_V + 2 * SHM_K;
    float* ws = (float*)(lds + 2 * SHM_V + 2 * SHM_K + 2 * SHM_KR) + wid * 64; float* li_l = ws, * al_l = ws + 32;
    float m_reg = -1e30f, l_reg = 0; f32x16 o[4] = {};
    const int sr = tid >> 4, sc = (tid & 15) * 8, vst0 = v_st(sr, sc), vst1 = v_st(32 + sr, sc), kws = KSWZ(sr, sc * 2), krws = (tid >> 3) * 144 + (tid & 7) * 16;
    const int vb0 = (int)(uintptr_t)V_lds + v_rd_base(lane);
    bf16x8 qr[12]; bf16x8 st_v0, st_v1, st_k0, st_k1, st_kr;
#pragma unroll
    for (int d0 = 0; d0 < 12; ++d0) qr[d0] = load8<bf16>(cur.Q + (size_t)(wid * QBLK + r32) * 192 + d0 * 16 + hi * 8);
    MSLOAD(cur, 0); VMW(); MSWRITE(0);
    __syncthreads();
    for (int t = 0; t < NT; ++t) {
        const int buf = t & 1, kb = t * KVBLK;
        if (t + 1 < NT) MSLOAD(cur, kb + KVBLK);
        if (kb <= qlo + QBLK - 1) {
            f32x16 p0, p1; float mn, alpha; bf16x8 pa0, pa1, pa2, pa3;
            SBAR(); qkt_mla<0>(p0, p1, K_lds + buf * SHM_K, KR_lds + buf * SHM_KR, r32, hi, qr);
            if (kb + KVBLK - 1 > qlo) mask_tile(p0, p1, qm - kb, 1u << 30);
            partialSM(p0, p1, m_reg, mn, alpha);
            if (__any(alpha < 1.f)) { if (hi == 0) al_l[r32] = alpha; asm volatile("s_waitcnt lgkmcnt(0)" ::: "memory");
#pragma unroll
                for (int d_ = 0; d_ < 4; ++d_)
#pragma unroll
                    for (int r = 0; r < 16; ++r) o[d_][r] *= al_l[crow(r, hi)]; }
            finishSM(p0, p1, alpha, l_reg, pa0, pa1, pa2, pa3); SBAR();
            pv_tile<0, false>(o, vb0 + buf * SHM_V, pa0, pa1, pa2, pa3, true);
        }
        if (t + 1 < NT) { VMW(); MSWRITE(buf ^ 1); }
        __syncthreads();
    }
    if (hi == 0) li_l[r32] = l_reg; asm volatile("s_waitcnt lgkmcnt(0)" ::: "memory");
    float rli[16];
#pragma unroll
    for (int r = 0; r < 16; ++r) rli[r] = __builtin_amdgcn_rcpf(li_l[crow(r, hi)]);
    bf16* Ow = cur.O + (size_t)(wid * QBLK) * MLA_OS;
#pragma unroll
    for (int r = 0; r < 16; ++r) { const int orow = crow(r, hi);
#pragma unroll
        for (int d0 = 0; d0 < 4; ++d0) { const float v = o[d0][r] * rli[r];
            const float vn = __shfl_xor(v, 1);
            if ((r32 & 1) == 0) *(unsigned*)(Ow + (size_t)orow * MLA_OS + d0 * 32 + r32) = cvtpk(v, vn); } }
    __syncthreads();
}
#undef MROW
#undef MSLOAD
#undef MSWRITE
constexpr float SB_STOP = -170.f;
constexpr int SB_OS = 1024;
__device__ __forceinline__ void sb_block(const bf16* Qb, const bf16* Kh, const bf16* Vh, bf16* Ob, int q0, char* lds) {
    int tid_ = threadIdx.x; asm volatile("" : "+v"(tid_));
    const int tid = tid_, wid = __builtin_amdgcn_readfirstlane(tid >> 6), lane = tid & 63, r32 = lane & 31, hi = lane >> 5;
    char* V_lds = lds; char* K_lds = lds + 2 * SHM_V; volatile __attribute__((address_space(3))) int* flags = (volatile __attribute__((address_space(3))) int*)(lds + 2 * SHM_V + 2 * SHM_K);
    const int sr = tid >> 4, sc = (tid & 15) * 8, vst0 = v_st(sr, sc), vst1 = v_st(32 + sr, sc), kws = KSWZ(sr, sc * 2);
    const int vb0 = (int)(uintptr_t)V_lds + v_rd_base(lane);
    bf16x8 qr[8];
#pragma unroll
    for (int d0 = 0; d0 < 8; ++d0) qr[d0] = load8<bf16>(Qb + (size_t)(wid * QBLK + r32) * D + d0 * 16 + hi * 8);
    const int qlo = q0 + wid * QBLK, trow = qlo + r32;
    float R = 0.f; f32x16 o[4] = {};
    bool wdone = false;
    bf16x8 st_v0, st_v1, st_k0, st_k1;
#define SBLOAD(k0) do { st_v0 = load8<bf16>(Vh + (size_t)((k0) + sr) * D + sc); st_v1 = load8<bf16>(Vh + (size_t)((k0) + 32 + sr) * D + sc); \
                        st_k0 = load8<bf16>(Kh + (size_t)((k0) + sr) * D + sc); st_k1 = load8<bf16>(Kh + (size_t)((k0) + 32 + sr) * D + sc); } while (0)
    int j = q0 / KVBLK + 3;
    SBLOAD(j * KVBLK);
    for (int it = 0; ; ++it, --j) {
        const int buf = it & 1;
        VMW();
        *(bf16x8*)(V_lds + buf * SHM_V + vst0) = st_v0; *(bf16x8*)(V_lds + buf * SHM_V + vst1) = st_v1;
        *(bf16x8*)(K_lds + buf * SHM_K + kws) = st_k0; *(bf16x8*)(K_lds + buf * SHM_K + kws + 32 * 256) = st_k1;
        __syncthreads();
        if (it > 0) { int all = 1;
#pragma unroll
            for (int w = 0; w < 8; ++w) all &= flags[((it - 1) & 1) * 8 + w];
            if (__builtin_amdgcn_readfirstlane(all)) break; }
        if (j > 0) SBLOAD((j - 1) * KVBLK);
        const int kb = j * KVBLK;
        const bool act = !wdone && (kb < qlo + QBLK - 1);
        if (act) {
            f32x16 p0, p1, l0, l1;
            qkt<0, false>(p0, p1, K_lds + buf * SHM_K, r32, hi, qr, true);
            const int dq = trow - kb - 4 * hi;
#pragma unroll
            for (int r = 0; r < 16; ++r) { const int c = (r & 3) + 8 * (r >> 2);
                const float z0 = p0[r], z1 = p1[r];
                const float a0 = -(fmaxf(z0, 0.f) + __builtin_amdgcn_logf(1.f + __builtin_amdgcn_exp2f(-fabsf(z0))));
                const float a1 = -(fmaxf(z1, 0.f) + __builtin_amdgcn_logf(1.f + __builtin_amdgcn_exp2f(-fabsf(z1))));
                l0[r] = (c < dq) ? a0 : 0.f; l1[r] = (c + 32 < dq) ? a1 : 0.f; }
            float gs[8], ot[8], E[8];
#pragma unroll
            for (int k = 0; k < 4; ++k) { gs[k] = (l0[4 * k] + l0[4 * k + 1]) + (l0[4 * k + 2] + l0[4 * k + 3]); gs[4 + k] = (l1[4 * k] + l1[4 * k + 1]) + (l1[4 * k + 2] + l1[4 * k + 3]); }
#pragma unroll
            for (int k = 0; k < 8; ++k) { const unsigned gu = __float_as_uint(gs[k]); auto rr = __builtin_amdgcn_permlane32_swap(gu, gu, false, false); ot[k] = __uint_as_float(hi ? rr[0] : rr[1]); }
            float acc = 0.f;
#pragma unroll
            for (int k = 7; k >= 0; --k) { E[k] = acc + (hi == 0 ? ot[k] : 0.f); acc += gs[k] + ot[k]; }
#pragma unroll
            for (int k = 0; k < 4; ++k) {
                float s0 = E[k] + R, s1 = E[4 + k] + R;
#pragma unroll
                for (int q = 3; q >= 0; --q) { const int r = 4 * k + q, c = (r & 3) + 8 * (r >> 2);
                    s0 += l0[r]; s1 += l1[r];
                    const float w0 = __builtin_amdgcn_exp2f(p0[r] + s0), w1 = __builtin_amdgcn_exp2f(p1[r] + s1);
                    p0[r] = (c < dq) ? w0 : 0.f; p1[r] = (c + 32 < dq) ? w1 : 0.f; }
            }
            R += acc;
            bf16x8 pa0, pa1, pa2, pa3;
#define PK4(P, B_, OUT) do { unsigned a0 = cvtpk(P[B_+0], P[B_+1]), a1 = cvtpk(P[B_+2], P[B_+3]);                          \
        unsigned b0 = cvtpk(P[B_+4], P[B_+5]), b1 = cvtpk(P[B_+6], P[B_+7]);                                             \
        auto r0 = __builtin_amdgcn_permlane32_swap(a0, b0, false, false); auto r1 = __builtin_amdgcn_permlane32_swap(a1, b1, false, false); \
        u32x4 w = {r0[0], r1[0], r0[1], r1[1]}; OUT = *reinterpret_cast<bf16x8*>(&w); } while (0)
            PK4(p0, 0, pa0); PK4(p0, 8, pa1); PK4(p1, 0, pa2); PK4(p1, 8, pa3);
#undef PK4
            SBAR();
            pv_tile<0, false>(o, vb0 + buf * SHM_V, pa0, pa1, pa2, pa3, true);
            wdone = __all(R < SB_STOP);
        }
        if (lane == 0) flags[(it & 1) * 8 + wid] = wdone ? 1 : 0;
        if (j == 0) break;
    }
#undef SBLOAD
    bf16* Ow = Ob + (size_t)(wid * QBLK) * SB_OS;
#pragma unroll
    for (int r = 0; r < 16; ++r) { const int orow = crow(r, hi);
#pragma unroll
        for (int d0 = 0; d0 < 4; ++d0) { const float v = o[d0][r];
            const float vn = __shfl_xor(v, 1);
            if ((r32 & 1) == 0) *(unsigned*)(Ow + (size_t)orow * SB_OS + d0 * 32 + r32) = cvtpk(v, vn); } }
    __syncthreads();
}
}
template <int KIND> __device__ __forceinline__ int srcmap(int n) {
    if constexpr (KIND == 1) {
        if (n < 4096) return n;
        if (n < 4160) { const int j = n - 4096; return 4096 + (j & 1) * 32 + (j >> 1); }
        if (n < 4352) return -1;
        return n - 192;
    } else if constexpr (KIND == 2) {
        const int h = n / 192, dd = n - h * 192;
        if (dd < 128) return n;
        const int j = dd - 128; return h * 192 + 128 + (j & 1) * 32 + (j >> 1);
    } else return n;
}
template <int KIND> __device__ __forceinline__ void tr_item(const float* __restrict__ W, int K, int Nsrc, const float* __restrict__ gk, bf16_t* WT, LAS float* scr, int item, int nblk, int lane) {
    const int kb = item / nblk, nb = item - kb * nblk, k0 = 64 * kb, n0 = 32 * nb;
    const int src = srcmap<KIND>(n0 + (lane & 31));
#pragma unroll 8
    for (int i = 0; i < 32; ++i) { const int kk = 2 * i + (lane >> 5); float v = 0.f; if (src >= 0) v = __builtin_nontemporal_load(&W[(size_t)(k0 + kk) * Nsrc + src]); if (gk) v *= gk[k0 + kk]; scr[kk * 33 + (lane & 31)] = v; }
    asm volatile("s_waitcnt lgkmcnt(0)" ::: "memory");
    const int c = lane & 7;
#pragma unroll
    for (int j = 0; j < 4; ++j) { const int n = (lane >> 3) + 8 * j; const LAS float* s = scr + (8 * c) * 33 + n;
        u32x4 o; o.x = pk2(s[0 * 33], s[1 * 33]); o.y = pk2(s[2 * 33], s[3 * 33]); o.z = pk2(s[4 * 33], s[5 * 33]); o.w = pk2(s[6 * 33], s[7 * 33]);
        *(u32x4*)(WT + (size_t)(n0 + n) * K + k0 + 8 * c) = o; }
    asm volatile("s_waitcnt lgkmcnt(0)" ::: "memory");
}

#ifndef PHASE_MASK
#define PHASE_MASK 0xFFFF
#endif
struct Params { const float* in[20]; float* out; unsigned char* ws; };

__global__ void __launch_bounds__(512, 2) fwd(Params P) {
    extern __shared__ __attribute__((aligned(16))) unsigned char lds_raw[];
    LAS unsigned char* lds = (LAS unsigned char*)lds_raw;
    const int tid = threadIdx.x, lane = tid & 63, wave = __builtin_amdgcn_readfirstlane(tid >> 6);
    const int G = gridDim.x, bx = blockIdx.x;
    const int vcu = (G % 8 == 0) ? (bx % 8) * (G / 8) + bx / 8 : bx;
    const int gw = vcu * 8 + wave, NGW = G * 8;
#define CAS __attribute__((address_space(4)))
#define KARG(off) ({ const CAS char* k_ = (const CAS char*)__builtin_amdgcn_kernarg_segment_ptr(); asm volatile("" : "+s"(k_)); *(const CAS unsigned long long*)(k_ + (off)); })
#define GAS __attribute__((address_space(1)))
#define INP(i) ((const float*)(const GAS float*)KARG(8 * (i)))
#define OUT_P ((float*)(GAS float*)KARG(160))
#define WS_P ((unsigned char*)(GAS unsigned char*)KARG(168))
#define X_IN INP(0)
#define P_IN INP(1)
#define POS_IN ((const int*)INP(2))
#define ssq_cq ((float*)(WS_P + WS_SSQ))
#define ssq_ckv (ssq_cq + T_TOK)
#define ssq_y (ssq_cq + 2 * T_TOK)
#define ssq_d (ssq_cq + 3 * T_TOK)
#define ssq_e (ssq_cq + 4 * T_TOK)
#define wb ((bf16_t*)(WS_P + WS_W))
#define XN ((bf16_t*)(WS_P + WS_XN))
#define SBQ ((bf16_t*)(WS_P + WS_SBQ))
#define SBK ((bf16_t*)(WS_P + WS_SBK))
#define SBV ((bf16_t*)(WS_P + WS_SBV))
#define CQ ((bf16_t*)(WS_P + WS_CQ))
#define CKV ((bf16_t*)(WS_P + WS_CKV))
#define QMLA ((bf16_t*)(WS_P + WS_QMLA))
#define KN ((bf16_t*)(WS_P + WS_KN))
#define VMLA ((bf16_t*)(WS_P + WS_VMLA))
#define KROPE ((bf16_t*)(WS_P + WS_KROPE))
#define OSB ((bf16_t*)(WS_P + WS_OSB))
#define OMLA ((bf16_t*)(WS_P + WS_OMLA))
#define EB ((bf16_t*)(WS_P + WS_E))
#define MIXED ((bf16_t*)(WS_P + WS_MIXED))
#define YB ((bf16_t*)(WS_P + WS_Y))
#define PB ((bf16_t*)(WS_P + WS_PB))
#define UB ((bf16_t*)(WS_P + WS_U))
#define DN ((bf16_t*)(WS_P + WS_DN))
#define SGS ((bf16_t*)OUT_P)
#define SGM (SGS + (size_t)T_TOK * DM)
    { volatile LAS unsigned* st0 = (volatile LAS unsigned*)(lds + 131072 + 64); if (tid == 0) { st0[0] = 0u; st0[1] = 0u; } __syncthreads(); }
    cg::this_grid().sync();
    const XcdBarrier xbar = xcd_barrier_post((unsigned*)(WS_P + WS_BAR), (volatile LAS unsigned*)(lds + 131072 + 64));
#define GRID_SYNC() xcd_barrier(xbar)

    if (PHASE_MASK & (1 << 0)) {
        for (int i = (bx * 512 + tid); i < 5 * T_TOK; i += G * 512) ssq_cq[i] = 0.f;
        LAS float* scr = (LAS float*)(lds + wave * 16384);
        constexpr int I0 = (2048 / 64) * (NIN / 32), I1 = (512 / 64) * (1536 / 32), I2 = (512 / 64) * (2048 / 32), I3 = (1024 / 64) * (2048 / 32), I4 = I3,
                      I5 = (2048 / 64) * (2048 / 32), I6 = (2048 / 64) * (8192 / 32), I7 = (8192 / 64) * (2048 / 32), I8 = (256 / 64) * (2048 / 32), I9 = I5;
        constexpr int NITEMS = I0 + I1 + I2 + I3 + I4 + I5 + I6 + I7 + I8 + I9;
        for (int it = gw; it < NITEMS; it += NGW) {
            int r = it;
            if (r < I0) { tr_item<1>(INP(4), 2048, 8256, nullptr, wb + OFF_WIN, scr, r, NIN / 32, lane); continue; } r -= I0;
            if (r < I1) { tr_item<2>(INP(7), 512, 1536, INP(5), wb + OFF_WQ, scr, r, 1536 / 32, lane); continue; } r -= I1;
            if (r < I2) { tr_item<0>(INP(8), 512, 2048, INP(6), wb + OFF_WKV, scr, r, 2048 / 32, lane); continue; } r -= I2;
            if (r < I3) { tr_item<0>(INP(9), 1024, 2048, nullptr, wb + OFF_WSBO, scr, r, 2048 / 32, lane); continue; } r -= I3;
            if (r < I4) { tr_item<0>(INP(10), 1024, 2048, nullptr, wb + OFF_WMLAO, scr, r, 2048 / 32, lane); continue; } r -= I4;
            if (r < I5) { tr_item<0>(INP(11), 2048, 2048, nullptr, wb + OFF_WOUT, scr, r, 2048 / 32, lane); continue; } r -= I5;
            if (r < I6) { tr_item<0>(INP(14), 2048, 8192, nullptr, wb + OFF_WUP, scr, r, 8192 / 32, lane); continue; } r -= I6;
            if (r < I7) { tr_item<0>(INP(15), 8192, 2048, nullptr, wb + OFF_WDOWN, scr, r, 2048 / 32, lane); continue; } r -= I7;
            if (r < I8) { tr_item<0>(INP(17), 256, 2048, nullptr, wb + OFF_WPLE, scr, r, 2048 / 32, lane); continue; } r -= I8;
            tr_item<0>(INP(19), 2048, 2048, nullptr, wb + OFF_WPG, scr, r, 2048 / 32, lane);
        }
        const f32x4* gr = (const f32x4*)INP(3) + lane;
        for (int m = gw; m < T_TOK; m += NGW) {
            const f32x4* xr = (const f32x4*)(X_IN + (size_t)m * DM) + lane; f32x4 v[8]; float s = 0.f;
#pragma unroll
            for (int j = 0; j < 8; ++j) { v[j] = __builtin_nontemporal_load(&xr[64 * j]); s += (v[j].x * v[j].x + v[j].y * v[j].y) + (v[j].z * v[j].z + v[j].w * v[j].w); }
            const float rs = __builtin_amdgcn_rsqf(wave_sum(s) * (1.f / DM) + EPS);
            u32x2* o = (u32x2*)(XN + (size_t)m * DM) + lane;
#pragma unroll
            for (int j = 0; j < 8; ++j) { const f32x4 g = gr[64 * j]; u32x2 w; w.x = pk2(v[j].x * rs * g.x, v[j].y * rs * g.y); w.y = pk2(v[j].z * rs * g.z, v[j].w * rs * g.w); o[64 * j] = w; }
        }
    }
    GRID_SYNC();

    if (PHASE_MASK & (1 << 1)) {
        pg8::Gemm g{XN, wb + OFF_WIN, T_TOK, NIN, 2048}; pg8::StaticOrder S; S.init(T_TOK, NIN, G, bx);
        Epi<EK_P1> E{}; E.a.o0 = SBQ; E.a.o1 = SBK; E.a.o2 = SBV; E.a.o3 = CQ; E.a.o4 = CKV; E.a.o5 = KROPE; E.a.o6 = SGS; E.a.o7 = SGM; E.a.ssq0 = ssq_cq; E.a.ssq1 = ssq_ckv; E.a.pos = POS_IN;
        pg8::gemm_phase<Epi<EK_P1>, pg8::StaticOrder, true, true>(lds, g, S, E);
    }
    GRID_SYNC();

    if (PHASE_MASK & (1 << 2)) {
        { pg8::Gemm g{CQ, wb + OFF_WQ, T_TOK, 1536, 512}; pg8::StaticOrder S; S.init(T_TOK, 1536, G, bx);
          Epi<EK_Q> E{}; E.a.o0 = QMLA; E.a.ssq0 = ssq_cq; E.a.pos = POS_IN;
          pg8::gemm_phase<Epi<EK_Q>, pg8::StaticOrder, true, true>(lds, g, S, E); }
        { pg8::Gemm g{CKV, wb + OFF_WKV, T_TOK, 2048, 512}; pg8::StaticOrder S; S.init(T_TOK, 2048, G, bx);
          Epi<EK_KV> E{}; E.a.o0 = KN; E.a.o1 = VMLA; E.a.ssq0 = ssq_ckv;
          pg8::gemm_phase<Epi<EK_KV>, pg8::StaticOrder, true, true>(lds, g, S, E); }
    }
    GRID_SYNC();

    if (PHASE_MASK & (1 << 3)) {
        char* al = (char*)lds_raw;
#ifndef REP_SB
#define REP_SB 1
#endif
#ifndef NO_SB
        for (int rep_ = 0; rep_ < REP_SB; ++rep_)
        for (int L = vcu; L < 32 * 32; L += G) {
            const int bh = L >> 5, qb = L & 31, b = bh >> 3, h = bh & 7;
            att::sb_block((const att::bf16*)SBQ + ((size_t)bh * SEQ + qb * 256) * 128, (const att::bf16*)SBK + (size_t)bh * SEQ * 128, (const att::bf16*)SBV + (size_t)bh * SEQ * 128,
                          (att::bf16*)OSB + ((size_t)(b * SEQ + qb * 256)) * 1024 + h * 128, qb * 256, al);
        }
#endif
#ifndef NO_MLA
#ifndef REP_MLA
#define REP_MLA 1
#endif
        for (int rep_ = 0; rep_ < REP_MLA; ++rep_)
        for (int L = vcu; L < 32 * 16; L += G) {
            const int bh = L >> 4, xq = L & 15, b = bh >> 3, h = bh & 7;
#pragma unroll 1
            for (int pass = 0; pass < 2; ++pass) { const int qb = pass ? 31 - xq : xq;
                att::MlaRef r; r.Q = (const att::bf16*)QMLA + ((size_t)bh * SEQ + qb * 256) * 192; r.K = (const att::bf16*)KN + (size_t)bh * SEQ * 128;
                r.KR = (const att::bf16*)KROPE + (size_t)b * SEQ * 64; r.V = (const att::bf16*)VMLA + (size_t)bh * SEQ * 128;
                r.O = (att::bf16*)OMLA + ((size_t)(b * SEQ + qb * 256)) * 1024 + h * 128; r.P0 = qb * 256;
                att::mla_block(r, al); }
        }
#endif
    }
    GRID_SYNC();

    if (PHASE_MASK & (1 << 4)) {
        { pg8::Gemm g{OSB, wb + OFF_WSBO, T_TOK, 2048, 1024}; pg8::StaticOrder S; S.init(T_TOK, 2048, G, bx);
          Epi<EK_MIX1> E{}; E.a.o0 = MIXED; E.a.g0 = SGS;
          pg8::gemm_phase<Epi<EK_MIX1>, pg8::StaticOrder, true, true>(lds, g, S, E); }
        { pg8::Gemm g{OMLA, wb + OFF_WMLAO, T_TOK, 2048, 1024}; pg8::StaticOrder S; S.init(T_TOK, 2048, G, bx);
          Epi<EK_MIX2> E{}; E.a.o0 = MIXED; E.a.g0 = SGM;
          pg8::gemm_phase<Epi<EK_MIX2>, pg8::StaticOrder, true, true>(lds, g, S, E); }
    }
    GRID_SYNC();

    if (PHASE_MASK & (1 << 5)) {
        pg8::Gemm g{MIXED, wb + OFF_WOUT, T_TOK, 2048, 2048}; pg8::StaticOrder S; S.init(T_TOK, 2048, G, bx);
        Epi<EK_SSQ> E{}; E.a.o0 = YB; E.a.ssq0 = ssq_y;
        pg8::gemm_phase<Epi<EK_SSQ>, pg8::StaticOrder, true, true>(lds, g, S, E);
    }
    GRID_SYNC();

    if (PHASE_MASK & (1 << 6)) {
        const f32x4* g1 = (const f32x4*)INP(12) + lane; const f32x4* g2 = (const f32x4*)INP(13) + lane;
        for (int m = gw; m < T_TOK; m += NGW) {
            const float rsy = __builtin_amdgcn_rsqf(ssq_y[m] * (1.f / DM) + EPS);
            const f32x4* xr = (const f32x4*)(X_IN + (size_t)m * DM) + lane; const u32x2* yr = (const u32x2*)(YB + (size_t)m * DM) + lane;
            f32x4* orow = (f32x4*)(OUT_P + (size_t)m * DM) + lane;
            f32x4 v[8]; float s = 0.f;
#pragma unroll
            for (int j = 0; j < 8; ++j) { const f32x4 xv = __builtin_nontemporal_load(&xr[64 * j]); const u32x2 yw = __builtin_nontemporal_load(&yr[64 * j]); const f32x4 g = g1[64 * j];
                f32x4 t; t.x = xv.x + bf_lo(yw.x) * rsy * g.x; t.y = xv.y + bf_hi(yw.x) * rsy * g.y; t.z = xv.z + bf_lo(yw.y) * rsy * g.z; t.w = xv.w + bf_hi(yw.y) * rsy * g.w;
                v[j] = t; __builtin_nontemporal_store(t, &orow[64 * j]); s += (t.x * t.x + t.y * t.y) + (t.z * t.z + t.w * t.w); }
            const float rs = __builtin_amdgcn_rsqf(wave_sum(s) * (1.f / DM) + EPS);
            u32x2* o = (u32x2*)(XN + (size_t)m * DM) + lane;
#pragma unroll
            for (int j = 0; j < 8; ++j) { const f32x4 g = g2[64 * j]; u32x2 w; w.x = pk2(v[j].x * rs * g.x, v[j].y * rs * g.y); w.y = pk2(v[j].z * rs * g.z, v[j].w * rs * g.w); o[64 * j] = w; }
            const f32x4 pv = ((const f32x4*)(P_IN + (size_t)m * PLE))[lane]; u32x2 pw; pw.x = pk2(pv.x, pv.y); pw.y = pk2(pv.z, pv.w);
            ((u32x2*)(PB + (size_t)m * PLE))[lane] = pw;
        }
    }
    GRID_SYNC();

    if (PHASE_MASK & (1 << 7)) {
#ifndef REP_UP
#define REP_UP 1
#endif
        for (int rep_ = 0; rep_ < REP_UP; ++rep_)
        { pg8::Gemm g{XN, wb + OFF_WUP, T_TOK, FF, 2048}; pg8::StaticOrder S; S.init(T_TOK, FF, G, bx);
          Epi<EK_UP> E{}; E.a.o0 = UB;
          pg8::gemm_phase<Epi<EK_UP>, pg8::StaticOrder, true, true>(lds, g, S, E); }
        { pg8::Gemm g{PB, wb + OFF_WPLE, T_TOK, 2048, 256}; pg8::StaticOrder S; S.init(T_TOK, 2048, G, bx);
          Epi<EK_SSQ> E{}; E.a.o0 = EB; E.a.ssq0 = ssq_e;
          pg8::gemm_phase<Epi<EK_SSQ>, pg8::StaticOrder, true, true>(lds, g, S, E); }
    }
    GRID_SYNC();

    if (PHASE_MASK & (1 << 8)) {
        pg8::Gemm g{UB, wb + OFF_WDOWN, T_TOK, 2048, FF}; pg8::StaticOrder S; S.init(T_TOK, 2048, G, bx);
        Epi<EK_SSQ> E{}; E.a.o0 = DN; E.a.ssq0 = ssq_d;
        pg8::gemm_phase<Epi<EK_SSQ>, pg8::StaticOrder, true, true>(lds, g, S, E);
    }
    GRID_SYNC();

    if (PHASE_MASK & (1 << 9)) {
        const f32x4* g1 = (const f32x4*)INP(16) + lane;
        for (int m = gw; m < T_TOK; m += NGW) {
            const float rsd = __builtin_amdgcn_rsqf(ssq_d[m] * (1.f / DM) + EPS);
            const u32x2* dr = (const u32x2*)(DN + (size_t)m * DM) + lane;
            f32x4* orow = (f32x4*)(OUT_P + (size_t)m * DM) + lane; u32x2* o = (u32x2*)(XN + (size_t)m * DM) + lane;
#pragma unroll
            for (int j = 0; j < 8; ++j) { const f32x4 xv = __builtin_nontemporal_load(&orow[64 * j]); const u32x2 dw = __builtin_nontemporal_load(&dr[64 * j]); const f32x4 g = g1[64 * j];
                f32x4 t; t.x = xv.x + bf_lo(dw.x) * rsd * g.x; t.y = xv.y + bf_hi(dw.x) * rsd * g.y; t.z = xv.z + bf_lo(dw.y) * rsd * g.z; t.w = xv.w + bf_hi(dw.y) * rsd * g.w;
                orow[64 * j] = t; u32x2 w; w.x = pk2(t.x, t.y); w.y = pk2(t.z, t.w); o[64 * j] = w; }
        }
    }
    GRID_SYNC();

    if (PHASE_MASK & (1 << 10)) {
        pg8::Gemm g{XN, wb + OFF_WPG, T_TOK, 2048, 2048}; pg8::StaticOrder S; S.init(T_TOK, 2048, G, bx);
        Epi<EK_FIN> E{}; E.a.g0 = EB; E.a.ssq0 = ssq_e; E.a.outf = OUT_P; E.a.gv = INP(18);
        pg8::gemm_phase<Epi<EK_FIN>, pg8::StaticOrder, true, true>(lds, g, S, E);
    }
}

extern "C" void kernel_launch(void* const* d_in, const int* in_sizes, int n_in, void* d_out, int out_size, void* d_ws, size_t ws_size, hipStream_t stream) {
    static int grid_blocks = 0;
    if (grid_blocks == 0) {
        if (n_in != 20 || out_size != T_TOK * DM || ws_size < WS_END) { fprintf(stderr, "kernel_launch: unexpected shapes (n_in %d out %d ws %zu)\n", n_in, out_size, ws_size); grid_blocks = -1; return; }
        int dev = 0, cus = 0, per_cu = 0;
        (void)hipGetDevice(&dev); (void)hipDeviceGetAttribute(&cus, hipDeviceAttributeMultiprocessorCount, dev);
        (void)hipFuncSetAttribute((const void*)fwd, hipFuncAttributeMaxDynamicSharedMemorySize, LDS_BYTES);
        (void)hipOccupancyMaxActiveBlocksPerMultiprocessor(&per_cu, (const void*)fwd, 512, LDS_BYTES);
        if (per_cu < 1) { fprintf(stderr, "kernel_launch: occupancy query says %d blocks per CU\n", per_cu); per_cu = 1; }
        grid_blocks = cus * per_cu;
    }
    if (grid_blocks < 0) return;
    (void)hipMemsetAsync((char*)d_ws + WS_BAR, 0, 16384, stream);
    Params p{};
    for (int i = 0; i < 20; ++i) p.in[i] = (const float*)d_in[i];
    p.out = (float*)d_out; p.ws = (unsigned char*)d_ws;
    void* args[] = {&p};
    hipError_t e = hipLaunchCooperativeKernel((const void*)fwd, dim3(grid_blocks), dim3(512), args, LDS_BYTES, stream);
    if (e != hipSuccess) fprintf(stderr, "cooperative launch failed: %s (grid %d)\n", hipGetErrorString(e), grid_blocks);
}
```

```cpp
#include <hip/hip_runtime.h>
#include <hip/hip_bf16.h>
#include <hip/hip_cooperative_groups.h>
#include <cstdio>
#include <cstdint>
namespace cg = cooperative_groups;
namespace pg8 {
#define PG8_LAS __attribute__((address_space(3)))
typedef unsigned short bf16_t;
typedef short bf16x8 __attribute__((ext_vector_type(8)));
typedef float f32x4 __attribute__((ext_vector_type(4)));
typedef unsigned u32x4 __attribute__((ext_vector_type(4)));
constexpr int BM = 256, BK = 64, HALF = 128, HTB = HALF * BK * 2  , STAGE_BYTES = 8 * HTB, NXCD = 8, WGM = 4;

__host__ __device__ __forceinline__ int lds_byte(int r, int c) { const int st = (r >> 4) * 2 + (c >> 5), rr = r & 15, cc = c & 31, ob = rr * 64 + cc * 2; return st * 1024 + (ob ^ (((ob >> 9) & 1) << 5)); }
__host__ __device__ __forceinline__ void stage_rc(int b, int& R, int& C) { const int st = b / 1024, sb = b % 1024, swz = sb ^ (((sb >> 9) & 1) << 5); R = (st >> 1) * 16 + swz / 64; C = (st & 1) * 32 + (swz % 64) / 2; }
__host__ __device__ __forceinline__ int perm32(int rho) { const int n = rho >> 4, i = rho & 15; return 8 * (i >> 2) + 4 * n + (i & 3); }

struct Unit { int pm, pn; };
struct Gemm { const bf16_t* A; const bf16_t* Bt; int M, N, K; };
struct StaticOrder {
    int nM, nN, nwg, G, c;
    __host__ __device__ void init(int M, int N, int G_, int c_) { nM = M / BM; nN = N / BM; nwg = nM * nN; G = G_; c = c_; }
    __host__ __device__ bool next(int i, Unit& u) const {
        const long L = (long)i * G + c; if (L >= nwg) return false;
        int wgid = (int)L; { const int q = nwg / NXCD, r = nwg % NXCD, xcd = wgid % NXCD, off = wgid / NXCD; wgid = (xcd < r ? xcd * (q + 1) : r * (q + 1) + (xcd - r) * q) + off; }
        const int nig = WGM * nN, gid = wgid / nig, fm = gid * WGM, gsz = (nM - fm) < WGM ? (nM - fm) : WGM;
        u.pm = fm + ((wgid % nig) % gsz); u.pn = (wgid % nig) / gsz; return true;
    }
    __device__ __forceinline__ void a_ready(const Unit&) const {}
    __device__ __forceinline__ void done(const Unit&) const {}
};
typedef float f32x2_cv __attribute__((ext_vector_type(2))); typedef __bf16 bf16x2_cv __attribute__((ext_vector_type(2)));
__device__ __forceinline__ unsigned cvt_pk_bf16(float lo, float hi) { f32x2_cv v = {lo, hi}; bf16x2_cv b = __builtin_convertvector(v, bf16x2_cv); return __builtin_bit_cast(unsigned, b); }
typedef float f32x2 __attribute__((ext_vector_type(2)));
template <class Epi, class Sched, bool ALIGN_EPI = false, bool SP2 = false>
__device__ __forceinline__ void gemm_phase(PG8_LAS unsigned char* lds, const Gemm g, const Sched& S, const Epi& E) {
    int tid_ = threadIdx.x; asm volatile("" : "+v"(tid_));
    const int tid = tid_, wid = __builtin_amdgcn_readfirstlane(tid >> 6), lane = tid & 63, wr = wid >> 2, wc = wid & 3, fr = lane & 15, fq = lane >> 4;
    const int K = g.K, nt = K / BK;
    unsigned voffA[2], voffB[2];
#pragma unroll
    for (int i = 0; i < 2; ++i) { int R, C; stage_rc(tid * 16 + i * 8192, R, C); const int Rb = Epi::PERM ? ((R & ~31) + perm32(R & 31)) : R;
        voffA[i] = (unsigned)(R * K + C) * 2u; voffB[i] = (unsigned)(Rb * K + C) * 2u; }
    const size_t kstep = (size_t)(BK * 2);
    const size_t hstep = (size_t)HALF * K * 2;
    const size_t tstep = 2 * hstep;
    const unsigned ldsw = (unsigned)wid * 1024u;
    const int aoff = lds_byte(wr * 64 + fr, fq * 8), boff = lds_byte(wc * 32 + fr, fq * 8);
#define PG8_SA(b, h) (((b) * 2 + (h)) * HTB)
#define PG8_SB(b, h) ((4 + (b) * 2 + (h)) * HTB)
#define PG8_STAGE(bufoff, gbase, voff) do { _Pragma("unroll") for (int _i = 0; _i < 2; ++_i) \
        __builtin_amdgcn_global_load_lds((const unsigned*)((const char*)(gbase) + (voff)[_i]), (PG8_LAS unsigned*)(lds + (bufoff) + ldsw + _i * 8192), 16, 0, 0); } while (0)
#define PG8_LDA(dst, b, h) do { _Pragma("unroll") for (int m = 0; m < 4; ++m) _Pragma("unroll") for (int k = 0; k < 2; ++k) dst[m][k] = *(const PG8_LAS bf16x8*)(lds + PG8_SA(b, h) + aoff + m * 2048 + k * 1024); } while (0)
#define PG8_LDB(dst, b, h) do { _Pragma("unroll") for (int n = 0; n < 2; ++n) _Pragma("unroll") for (int k = 0; k < 2; ++k) dst[n][k] = *(const PG8_LAS bf16x8*)(lds + PG8_SB(b, h) + boff + n * 2048 + k * 1024); } while (0)
#define PG8_MMA(ai, bj, At, Bt) do { __builtin_amdgcn_s_setprio(1); _Pragma("unroll") for (int m = 0; m < 4; ++m) _Pragma("unroll") for (int n = 0; n < 2; ++n) _Pragma("unroll") for (int k = 0; k < 2; ++k) \
        acc[ai][bj][m][n] = __builtin_amdgcn_mfma_f32_16x16x32_bf16(Bt[n][k], At[m][k], acc[ai][bj][m][n], 0, 0, 0); __builtin_amdgcn_s_setprio(0); } while (0)
#define PG8_WAIT_V(n) asm volatile("s_waitcnt vmcnt(" #n ")" ::: "memory")
#define PG8_WAIT_L(n) asm volatile("s_waitcnt lgkmcnt(" #n ")" ::: "memory")
#define PG8_BAR __builtin_amdgcn_s_barrier()
#define PG8_SCHED __builtin_amdgcn_sched_barrier(0)
    Unit cur, nxt; int ui = 0;
    if (!S.next(0, cur)) return;
    f32x4 acc[2][2][4][2];
#pragma unroll
    for (int a = 0; a < 2; ++a)
#pragma unroll
        for (int b = 0; b < 2; ++b)
#pragma unroll
            for (int m = 0; m < 4; ++m)
#pragma unroll
                for (int n = 0; n < 2; ++n) acc[a][b][m][n] = (f32x4){0.f, 0.f, 0.f, 0.f};
    bf16x8 At[4][2], B0[2][2], B1[2][2];
    const char* cA = (const char*)g.A + (size_t)cur.pm * tstep; const char* cB = (const char*)g.Bt + (size_t)cur.pn * tstep;
    S.a_ready(cur);
    if constexpr (SP2) {
        PG8_STAGE(PG8_SB(0, 0), cB, voffB); PG8_STAGE(PG8_SB(0, 1), cB + hstep, voffB); PG8_STAGE(PG8_SA(0, 0), cA, voffA); PG8_STAGE(PG8_SA(0, 1), cA + hstep, voffA);
        if (wr == 1) PG8_BAR;
        PG8_WAIT_V(2); PG8_BAR;
        PG8_STAGE(PG8_SB(1, 0), cB + kstep, voffB); PG8_STAGE(PG8_SA(1, 0), cA + kstep, voffA); PG8_STAGE(PG8_SB(1, 1), cB + hstep + kstep, voffB);
        PG8_WAIT_V(6); PG8_BAR;
    } else {
        PG8_STAGE(PG8_SB(0, 0), cB, voffB); PG8_STAGE(PG8_SA(0, 0), cA, voffA); PG8_STAGE(PG8_SB(0, 1), cB + hstep, voffB); PG8_STAGE(PG8_SA(0, 1), cA + hstep, voffA);
        if (wr == 1) PG8_BAR;
        PG8_WAIT_V(4); PG8_BAR;
        PG8_STAGE(PG8_SB(1, 0), cB + kstep, voffB); PG8_STAGE(PG8_SA(1, 0), cA + kstep, voffA); PG8_STAGE(PG8_SB(1, 1), cB + hstep + kstep, voffB);
        PG8_WAIT_V(6); PG8_BAR;
    }
    for (;;) {
        const bool has_next = S.next(ui + 1, nxt);
        const char* nA = has_next ? (const char*)g.A + (size_t)nxt.pm * tstep : cA; const char* nB = has_next ? (const char*)g.Bt + (size_t)nxt.pn * tstep : cB;
        for (int t = 0; t < nt; t += 2) {
            const bool last = (t == nt - 2);
            const char* a1 = cA + (size_t)(t + 1) * kstep;
            const char* a2 = last ? nA : cA + (size_t)(t + 2) * kstep; const char* b2 = last ? nB : cB + (size_t)(t + 2) * kstep;
            const char* a3 = a2 + kstep; const char* b3 = b2 + kstep;
            if (last && has_next) S.a_ready(nxt);
            if constexpr (SP2) {
            PG8_LDB(B0, 0, 0); PG8_LDB(B1, 0, 1); PG8_SCHED; PG8_LDA(At, 0, 0); PG8_STAGE(PG8_SA(1, 1), a1 + hstep, voffA);
            PG8_WAIT_V(8); PG8_WAIT_L(0); PG8_BAR; PG8_MMA(0, 0, At, B0); PG8_MMA(0, 1, At, B1); PG8_BAR; PG8_SCHED;
            PG8_LDA(At, 0, 1); PG8_STAGE(PG8_SB(0, 0), b2, voffB); PG8_STAGE(PG8_SB(0, 1), b2 + hstep, voffB); PG8_STAGE(PG8_SA(0, 0), a2, voffA);
            PG8_WAIT_V(8); PG8_WAIT_L(0); PG8_BAR; PG8_MMA(1, 0, At, B0); PG8_MMA(1, 1, At, B1); PG8_BAR; PG8_SCHED;
            PG8_LDB(B0, 1, 0); PG8_LDB(B1, 1, 1); PG8_SCHED; PG8_LDA(At, 1, 0); PG8_STAGE(PG8_SA(0, 1), a2 + hstep, voffA);
            PG8_WAIT_V(8); PG8_WAIT_L(0); PG8_BAR; PG8_MMA(0, 0, At, B0); PG8_MMA(0, 1, At, B1); PG8_BAR; PG8_SCHED;
            PG8_LDA(At, 1, 1); PG8_STAGE(PG8_SB(1, 0), b3, voffB); PG8_STAGE(PG8_SB(1, 1), b3 + hstep, voffB); PG8_STAGE(PG8_SA(1, 0), a3, voffA);
            PG8_WAIT_V(8); PG8_WAIT_L(0); PG8_BAR; PG8_MMA(1, 0, At, B0); PG8_MMA(1, 1, At, B1); PG8_BAR; PG8_SCHED;
            } else {
            PG8_LDB(B0, 0, 0); PG8_SCHED; PG8_LDA(At, 0, 0); PG8_STAGE(PG8_SA(1, 1), a1 + hstep, voffA);
            PG8_WAIT_L(8); PG8_BAR; PG8_WAIT_L(0); PG8_MMA(0, 0, At, B0); PG8_BAR; PG8_SCHED;
            PG8_LDB(B1, 0, 1); PG8_STAGE(PG8_SB(0, 0), b2, voffB);
            PG8_BAR; PG8_WAIT_L(0); PG8_MMA(0, 1, At, B1); PG8_BAR;
            PG8_LDA(At, 0, 1); PG8_STAGE(PG8_SA(0, 0), a2, voffA);
            PG8_BAR; PG8_WAIT_L(0); PG8_MMA(1, 0, At, B0); PG8_BAR; PG8_SCHED;
            PG8_STAGE(PG8_SB(0, 1), b2 + hstep, voffB);
            PG8_WAIT_V(6); PG8_BAR; PG8_MMA(1, 1, At, B1); PG8_BAR;
            PG8_LDB(B0, 1, 0); PG8_SCHED; PG8_LDA(At, 1, 0); PG8_STAGE(PG8_SA(0, 1), a2 + hstep, voffA);
            PG8_WAIT_L(8); PG8_BAR; PG8_WAIT_L(0); PG8_MMA(0, 0, At, B0); PG8_BAR; PG8_SCHED;
            PG8_LDB(B1, 1, 1); PG8_STAGE(PG8_SB(1, 0), b3, voffB);
            PG8_BAR; PG8_WAIT_L(0); PG8_MMA(0, 1, At, B1); PG8_BAR;
            PG8_LDA(At, 1, 1); PG8_STAGE(PG8_SA(1, 0), a3, voffA);
            PG8_BAR; PG8_WAIT_L(0); PG8_MMA(1, 0, At, B0); PG8_BAR; PG8_SCHED;
            PG8_STAGE(PG8_SB(1, 1), b3 + hstep, voffB);
            PG8_WAIT_V(6); PG8_BAR; PG8_MMA(1, 1, At, B1); PG8_BAR;
            }
        }
        if constexpr (ALIGN_EPI) { if (wr == 0) PG8_BAR; }
        if constexpr (!Epi::AFTER_DRAIN) { E(acc, cur, wr, wc, fr, fq); S.done(cur); }
        if (!has_next) break;
#pragma unroll
        for (int a = 0; a < 2; ++a)
#pragma unroll
            for (int b = 0; b < 2; ++b)
#pragma unroll
                for (int m = 0; m < 4; ++m)
#pragma unroll
                    for (int n = 0; n < 2; ++n) acc[a][b][m][n] = (f32x4){0.f, 0.f, 0.f, 0.f};
        cur = nxt; cA = nA; cB = nB; ++ui;
        if constexpr (ALIGN_EPI) { if (wr == 1) PG8_BAR; }
    }
    PG8_WAIT_V(0);
    if constexpr (!ALIGN_EPI) { if (wr == 0) PG8_BAR; }
    PG8_BAR;
    if constexpr (Epi::AFTER_DRAIN) { E.fused(acc, cur, wr, wc, fr, fq, lds, wid, lane); S.done(cur); }
#undef PG8_SA
#undef PG8_SB
#undef PG8_STAGE
#undef PG8_LDA
#undef PG8_LDB
#undef PG8_MMA
#undef PG8_WAIT_V
#undef PG8_WAIT_L
#undef PG8_BAR
#undef PG8_SCHED
}
}
constexpr int T_TOK = 32768, SEQ = 8192, DM = 2048, NH = 8, FF = 8192, PLE = 256;
constexpr int NIN = 8448;
constexpr float EPS = 1e-6f;
constexpr float LOG2E = 1.4426950408889634f;
constexpr float SB_QSCALE = 0.08838834764831845f * LOG2E;
constexpr size_t MiB = 1u << 20;
constexpr size_t WS_BAR = 768 * 1024;
constexpr size_t WS_SSQ = 0;
constexpr size_t WS_W = 1 * MiB;
constexpr size_t OFF_WIN = 0, OFF_WQ = 17301504, OFF_WKV = 18087936, OFF_WSBO = 19136512, OFF_WMLAO = 21233664, OFF_WOUT = 23330816,
                 OFF_WUP = 27525120, OFF_WDOWN = 44302336, OFF_WPLE = 61079552, OFF_WPG = 61603840;
constexpr size_t WS_XN = 128 * MiB;
constexpr size_t WS_SBQ = 256 * MiB, WS_SBK = 320 * MiB, WS_SBV = 384 * MiB, WS_CQ = 448 * MiB, WS_CKV = 480 * MiB, WS_QMLA = 512 * MiB,
                 WS_KN = 608 * MiB, WS_VMLA = 672 * MiB, WS_KROPE = 736 * MiB, WS_OSB = 768 * MiB, WS_OMLA = 832 * MiB, WS_E = 896 * MiB;
constexpr size_t WS_MIXED = 256 * MiB, WS_Y = 384 * MiB, WS_PB = 768 * MiB, WS_U = 256 * MiB, WS_DN = 768 * MiB, WS_END = 1024 * MiB;
constexpr int LDS_BYTES = 132096;

typedef unsigned short bf16_t;
typedef float f32x4 __attribute__((ext_vector_type(4)));
typedef unsigned u32x4 __attribute__((ext_vector_type(4)));
typedef unsigned u32x2 __attribute__((ext_vector_type(2)));
#define LAS __attribute__((address_space(3)))

__device__ __forceinline__ unsigned pk2(float lo, float hi) { return pg8::cvt_pk_bf16(lo, hi); }
__device__ __forceinline__ float bf_lo(unsigned w) { return __uint_as_float(w << 16); }
__device__ __forceinline__ float bf_hi(unsigned w) { return __uint_as_float(w & 0xffff0000u); }
__device__ __forceinline__ void store8(bf16_t* dst, const float* v) { u32x4 w; w.x = pk2(v[0], v[1]); w.y = pk2(v[2], v[3]); w.z = pk2(v[4], v[5]); w.w = pk2(v[6], v[7]); *(u32x4*)dst = w; }
__device__ __forceinline__ void store8_nt(bf16_t* dst, const float* v) { u32x4 w; w.x = pk2(v[0], v[1]); w.y = pk2(v[2], v[3]); w.z = pk2(v[4], v[5]); w.w = pk2(v[6], v[7]); __builtin_nontemporal_store(w, (u32x4*)dst); }
__device__ __forceinline__ void load8(const bf16_t* src, float* v) { const u32x4 w = *(const u32x4*)src; v[0] = bf_lo(w.x); v[1] = bf_hi(w.x); v[2] = bf_lo(w.y); v[3] = bf_hi(w.y); v[4] = bf_lo(w.z); v[5] = bf_hi(w.z); v[6] = bf_lo(w.w); v[7] = bf_hi(w.w); }
__device__ __forceinline__ float sigmoidf_(float v) { return __builtin_amdgcn_rcpf(1.f + __builtin_amdgcn_exp2f(-v * LOG2E)); }
__device__ __forceinline__ float wave_sum(float v) {
#pragma unroll
    for (int o = 1; o < 64; o <<= 1) v += __shfl_xor(v, o);
    return v;
}
__device__ __forceinline__ void rope_pair(float& a, float& b, int pos, int i) {
    const float inv = __builtin_amdgcn_exp2f(-(float)i * 0.41524101186092029f);
    const float ang = (float)pos * inv;
    double rev = (double)ang * 0.15915494309189535;
    rev -= __builtin_rint(rev);
    const float fr = (float)rev;
    const float s = __builtin_amdgcn_sinf(fr), c = __builtin_amdgcn_cosf(fr);
    const float na = a * c - b * s, nb = a * s + b * c; a = na; b = nb;
}

struct EpiArgs {
    bf16_t* o0; bf16_t* o1; bf16_t* o2;
    bf16_t* o3; bf16_t* o4; bf16_t* o5; bf16_t* o6; bf16_t* o7;
    float* ssq0; float* ssq1;
    const bf16_t* g0; const bf16_t* g1;
    const int* pos; float* outf; const float* gv;
};
enum { EK_P1 = 0, EK_Q = 1, EK_KV = 2, EK_MIX1 = 3, EK_MIX2 = 4, EK_SSQ = 5, EK_UP = 6, EK_FIN = 7 };
template <int KIND> struct Epi {
    static constexpr bool PERM = true, AFTER_DRAIN = false;
    EpiArgs a;
    __device__ __forceinline__ void operator()(const pg8::f32x4 (&acc)[2][2][4][2], const pg8::Unit& u, int wr, int wc, int fr, int fq) const {
        const int pn = u.pn;
#pragma unroll
        for (int ai = 0; ai < 2; ++ai)
#pragma unroll
            for (int m = 0; m < 4; ++m) {
                const int row = u.pm * 256 + ai * 128 + wr * 64 + m * 16 + fr;
                const int bb = row >> 13, ss = row & 8191;
                float ssq = 0.f;
                float rs = 1.f;
                if constexpr (KIND == EK_Q || KIND == EK_KV) rs = __builtin_amdgcn_rsqf(a.ssq0[row] * (1.f / 512.f) + EPS);
                if constexpr (KIND == EK_FIN) rs = __builtin_amdgcn_rsqf(a.ssq0[row] * (1.f / 2048.f) + EPS);
#pragma unroll
                for (int bj = 0; bj < 2; ++bj) {
                    const int cl = bj * 128 + wc * 32 + fq * 8;
                    float v[8];
#pragma unroll
                    for (int j = 0; j < 4; ++j) { v[j] = acc[ai][bj][m][0][j]; v[4 + j] = acc[ai][bj][m][1][j]; }
                    if constexpr (KIND == EK_P1) {
                        if (pn < 12) {
                            const int t = pn >> 2, c = (pn & 3) * 256 + cl, h = c >> 7, d = c & 127;
                            if (t == 0) {
#pragma unroll
                                for (int j = 0; j < 8; ++j) v[j] *= SB_QSCALE;
                            }
                            bf16_t* base = t == 0 ? a.o0 : (t == 1 ? a.o1 : a.o2);
                            store8(base + ((size_t)((bb * NH + h) * SEQ + ss)) * 128 + d, v);
                        } else if (pn < 16) {
                            const int t = (pn - 12) >> 1, c = ((pn - 12) & 1) * 256 + cl;
#pragma unroll
                            for (int j = 0; j < 8; ++j) ssq += v[j] * v[j];
                            store8((t ? a.o4 : a.o3) + (size_t)row * 512 + c, v);
                        } else if (pn == 16) {
                            if (cl < 64) {
                                const int p = a.pos[row];
#pragma unroll
                                for (int j = 0; j < 4; ++j) rope_pair(v[2 * j], v[2 * j + 1], p, (cl >> 1) + j);
                                store8(a.o5 + (size_t)row * 64 + cl, v);
                            }
                        } else {
                            const int t = (pn - 17) >> 3, c = ((pn - 17) & 7) * 256 + cl;
#pragma unroll
                            for (int j = 0; j < 8; ++j) v[j] = sigmoidf_(v[j]);
                            store8_nt((t ? a.o7 : a.o6) + (size_t)row * 2048 + c, v);
                        }
                    } else if constexpr (KIND == EK_Q) {
                        const int c = pn * 256 + cl, h = c / 192, dd = c - h * 192;
#pragma unroll
                        for (int j = 0; j < 8; ++j) v[j] *= rs;
                        if (dd >= 128) {
                            const int p = a.pos[row];
#pragma unroll
                            for (int j = 0; j < 4; ++j) rope_pair(v[2 * j], v[2 * j + 1], p, ((dd - 128) >> 1) + j);
                        }
                        store8(a.o0 + ((size_t)((bb * NH + h) * SEQ + ss)) * 192 + dd, v);
                    } else if constexpr (KIND == EK_KV) {
#pragma unroll
                        for (int j = 0; j < 8; ++j) v[j] *= rs;
                        store8((bj ? a.o1 : a.o0) + ((size_t)((bb * NH + pn) * SEQ + ss)) * 128 + (cl & 127), v);
                    } else if constexpr (KIND == EK_MIX1) {
                        const size_t off = (size_t)row * 2048 + pn * 256 + cl; float g[8]; load8(a.g0 + off, g);
#pragma unroll
                        for (int j = 0; j < 8; ++j) v[j] *= g[j];
                        store8(a.o0 + off, v);
                    } else if constexpr (KIND == EK_MIX2) {
                        const size_t off = (size_t)row * 2048 + pn * 256 + cl; float g[8], pr[8]; load8(a.g0 + off, g); load8(a.o0 + off, pr);
#pragma unroll
                        for (int j = 0; j < 8; ++j) v[j] = pr[j] + v[j] * g[j];
                        store8(a.o0 + off, v);
                    } else if constexpr (KIND == EK_SSQ) {
#pragma unroll
                        for (int j = 0; j < 8; ++j) ssq += v[j] * v[j];
                        store8(a.o0 + (size_t)row * 2048 + pn * 256 + cl, v);
                    } else if constexpr (KIND == EK_UP) {
#pragma unroll
                        for (int j = 0; j < 8; ++j) { const float r = fmaxf(v[j], 0.f); v[j] = r * r; }
                        { u32x4 w; w.x = pk2(v[0], v[1]); w.y = pk2(v[2], v[3]); w.z = pk2(v[4], v[5]); w.w = pk2(v[6], v[7]); __builtin_nontemporal_store(w, (u32x4*)(a.o0 + (size_t)row * FF + pn * 256 + cl)); }
                    } else if constexpr (KIND == EK_FIN) {
                        const int c = pn * 256 + cl; const size_t off = (size_t)row * 2048 + c; float e[8]; load8(a.g0 + off, e);
                        const f32x4 x0 = *(const f32x4*)(a.outf + off), x1 = *(const f32x4*)(a.outf + off + 4);
                        const f32x4 g0 = *(const f32x4*)(a.gv + c), g1 = *(const f32x4*)(a.gv + c + 4);
                        f32x4 r0, r1;
#pragma unroll
                        for (int j = 0; j < 4; ++j) { r0[j] = x0[j] + sigmoidf_(v[j]) * (e[j] * rs * g0[j]); r1[j] = x1[j] + sigmoidf_(v[4 + j]) * (e[4 + j] * rs * g1[j]); }
                        *(f32x4*)(a.outf + off) = r0; *(f32x4*)(a.outf + off + 4) = r1;
                    }
                }
                if constexpr (KIND == EK_P1) {
                    if (pn >= 12 && pn < 16) { ssq += __shfl_xor(ssq, 16); ssq += __shfl_xor(ssq, 32); if (fq == 0) atomicAdd((pn >= 14 ? a.ssq1 : a.ssq0) + row, ssq); }
                }
                if constexpr (KIND == EK_SSQ) { ssq += __shfl_xor(ssq, 16); ssq += __shfl_xor(ssq, 32); if (fq == 0) atomicAdd(a.ssq0 + row, ssq); }
            }
    }
};
#define XB_TMO      128
#define XB_XCNT(j)  (256  + 64 * (j))
#define XB_XSUB(j)  (1280 + 64 * (j))
#define XB_XGEN(j)  (2304 + 64 * (j))
#define XB_TOP      3328
#define XB_TOPGEN   3392
#define XCD_BAR_WORDS 3456
#define XB_SPIN_CAP (1u << 18)

__device__ __forceinline__ unsigned xb_ld(unsigned* p)              { return __hip_atomic_load(p, __ATOMIC_RELAXED, __HIP_MEMORY_SCOPE_AGENT); }
__device__ __forceinline__ unsigned xb_add(unsigned* p, unsigned v) { return __hip_atomic_fetch_add(p, v, __ATOMIC_RELAXED, __HIP_MEMORY_SCOPE_AGENT); }
__device__ __forceinline__ unsigned xb_xcc_id() { return (unsigned)__builtin_amdgcn_s_getreg((3 << 11) | 20) & 0xFu; }
#define XB_SPIN(cond, bar) do { unsigned _sp = 0; while (cond) { __builtin_amdgcn_s_sleep(1); \
    if ((++_sp & 255u) == 0u) { if (xb_ld(&(bar)[XB_TMO])) break; if (_sp > XB_SPIN_CAP) { atomicAdd(&(bar)[XB_TMO], 1u); break; } } } } while (0)

struct XcdBarrier {
    unsigned* bar; unsigned x;
    volatile LAS unsigned* st;
};

__device__ __forceinline__ XcdBarrier xcd_barrier_post(unsigned* bar, volatile LAS unsigned* st) {
    XcdBarrier b; b.bar = bar; b.x = xb_xcc_id(); b.st = st;
    if (threadIdx.x == 0) (void)xb_add(&bar[XB_XCNT(b.x)], 1u);
    return b;
}
__device__ __forceinline__ void xcd_barrier_complete(unsigned* bar, unsigned x, unsigned& nloc, unsigned& nx) {
    const unsigned G = gridDim.x * gridDim.y * gridDim.z;
    unsigned sum, cnt, mine, sp = 0u;
    for (;;) {
        sum = 0u; cnt = 0u; mine = 0u;
#pragma unroll
        for (unsigned j = 0; j < 16; ++j) { const unsigned c = xb_ld(&bar[XB_XCNT(j)]); sum += c; cnt += (c > 0u) ? 1u : 0u; mine = (j == x) ? c : mine; }
        if (sum == G) break;
        __builtin_amdgcn_s_sleep(1);
        if ((++sp & 255u) == 0u) { if (xb_ld(&bar[XB_TMO])) break; if (sp > XB_SPIN_CAP) { atomicAdd(&bar[XB_TMO], 1u); break; } }
    }
    nloc = mine > 0u ? mine : 1u; nx = cnt > 0u ? cnt : 1u;
}

__device__ __forceinline__ void xcd_barrier(const XcdBarrier& b) {
    asm volatile("s_waitcnt vmcnt(0)" ::: "memory");
    __syncthreads();
    if (threadIdx.x == 0) {
        unsigned* bar = b.bar;
        __builtin_amdgcn_s_waitcnt(0);
        unsigned nloc = b.st[0], nx = b.st[1];
        if (nloc == 0u) { xcd_barrier_complete(bar, b.x, nloc, nx); b.st[0] = nloc; b.st[1] = nx; }
        const unsigned old = xb_add(&bar[XB_XSUB(b.x)], 1u);
        const unsigned gen = old / nloc;
        if (old + 1u == (gen + 1u) * nloc) {
            __builtin_amdgcn_fence(__ATOMIC_RELEASE, "agent");
            asm volatile("s_waitcnt vmcnt(0)" ::: "memory");
            const unsigned og = xb_add(&bar[XB_TOP], 1u);
            const unsigned tg = og / nx;
            if (og + 1u == (tg + 1u) * nx) xb_add(&bar[XB_TOPGEN], 1u);
            else XB_SPIN(xb_ld(&bar[XB_TOPGEN]) == tg, bar);
            __builtin_amdgcn_fence(__ATOMIC_ACQUIRE, "agent");
            xb_add(&bar[XB_XGEN(b.x)], 1u);
            asm volatile("s_waitcnt vmcnt(0)" ::: "memory");
        } else {
            XB_SPIN(xb_ld(&bar[XB_XGEN(b.x)]) == gen, bar);
            __builtin_amdgcn_fence(__ATOMIC_ACQUIRE, "agent");
            asm volatile("s_waitcnt vmcnt(0)" ::: "memory");
        }
    }
    __syncthreads();
}
namespace att {
using bf16 = __hip_bfloat16;
typedef short bf16x8 __attribute__((ext_vector_type(8)));
typedef short s16x4 __attribute__((ext_vector_type(4)));
typedef float f32x16 __attribute__((ext_vector_type(16)));
typedef float f32x4 __attribute__((ext_vector_type(4)));
typedef unsigned u32x4 __attribute__((ext_vector_type(4)));
template <class A, class Bt> struct same_t { static constexpr bool v = false; };
template <class A> struct same_t<A, A> { static constexpr bool v = true; };
constexpr int D = 128, NW = 8, QBLK = 32, KVBLK = 64, QB = NW * QBLK;
constexpr int SHM_V = KVBLK * D * 2, SHM_K = KVBLK * D * 2, SHM_KR = 64 * 144;
constexpr float SCALE = 0.07216878364870323f;
constexpr float THR = 8.f;
constexpr bool WSKIP = false;
#define KSWZ(row, colB) ((row) * 256 + ((colB) ^ (((row) & 7) << 4)))
#define SBAR() __builtin_amdgcn_sched_barrier(0)
__device__ __forceinline__ int v_st(int k, int c) { const int kk = (k & ~0xC) | ((k & 4) << 1) | ((k & 8) >> 1); return ((kk >> 3) * 4 + (c >> 5)) * 512 + ((kk & 7) * 32 + (c & 31)) * 2; }
__device__ __forceinline__ int v_rd_base(int lane) { return ((lane & 3) << 3) | (((lane >> 2) & 3) << 6) | (((lane >> 4) & 1) << 5) | (((lane >> 5) & 1) << 8); }
constexpr int v_rd_off(int d0, int ks, int half) { return d0 * 512 + ks * 4096 + half * 2048; }
__device__ __forceinline__ int crow(int r, int hi) { return (r & 3) + 8 * (r >> 2) + 4 * hi; }
__device__ __forceinline__ unsigned cvtpk(float lo, float hi) {
    typedef float f32x2_cv __attribute__((ext_vector_type(2))); typedef __bf16 bf16x2_cv __attribute__((ext_vector_type(2)));
    f32x2_cv v = {lo, hi}; bf16x2_cv b = __builtin_convertvector(v, bf16x2_cv); return __builtin_bit_cast(unsigned, b);
}
__device__ __forceinline__ bf16x8 pack8(f32x4 a, f32x4 b) {
    u32x4 w = {cvtpk(a[0], a[1]), cvtpk(a[2], a[3]), cvtpk(b[0], b[1]), cvtpk(b[2], b[3])};
    return *reinterpret_cast<bf16x8*>(&w);
}
template <class T> __device__ __forceinline__ bf16x8 load8(const T* p) {
    if constexpr (same_t<T, float>::v) { return pack8(*(const f32x4*)p, *(const f32x4*)(p + 4)); }
    else { return *reinterpret_cast<const bf16x8*>(p); }
}
__device__ __forceinline__ void mask_tile(f32x16& p0, f32x16& p1, int dq, unsigned W) {
    const float NEG = -__builtin_inff();
#pragma unroll
    for (int r = 0; r < 16; ++r) {
        const int c = (r & 3) + 8 * (r >> 2);
        if ((unsigned)(dq - c) >= W) p0[r] = NEG;
        if ((unsigned)(dq - c - 32) >= W) p1[r] = NEG;
    }
}
__device__ __forceinline__ void partialSM(f32x16& p0, f32x16& p1, float& m_reg, float& mn, float& alpha) {
    float pmax = p0[0]; for (int r = 1; r < 16; ++r) pmax = fmaxf(pmax, p0[r]); for (int r = 0; r < 16; ++r) pmax = fmaxf(pmax, p1[r]);
    { auto rr = __builtin_amdgcn_permlane32_swap(__float_as_uint(pmax), __float_as_uint(pmax), false, false);
      pmax = fmaxf(__uint_as_float(rr[0]), __uint_as_float(rr[1])); }
    constexpr float C2 = 1.4426950408889634f * SCALE;
    if (__builtin_expect(__all((pmax - m_reg) * SCALE <= THR), 1)) { mn = m_reg; alpha = 1.f; }
    else { mn = fmaxf(m_reg, pmax); alpha = __builtin_amdgcn_exp2f((m_reg - mn) * C2); m_reg = mn; }
    const float mnL = -mn * C2;
    for (int r = 0; r < 16; ++r) p0[r] = fmaf(p0[r], C2, mnL); for (int r = 0; r < 16; ++r) p1[r] = fmaf(p1[r], C2, mnL);
    for (int r = 0; r < 16; ++r) p0[r] = __builtin_amdgcn_exp2f(p0[r]);
}
__device__ __forceinline__ void finishSM(f32x16& p0, f32x16& p1, float alpha, float& l_reg, bf16x8& pa0, bf16x8& pa1, bf16x8& pa2, bf16x8& pa3) {
    for (int r = 0; r < 16; ++r) p1[r] = __builtin_amdgcn_exp2f(p1[r]);
    float ps = 0; for (int r = 0; r < 16; ++r) ps += p0[r]; for (int r = 0; r < 16; ++r) ps += p1[r];
    { auto rr = __builtin_amdgcn_permlane32_swap(__float_as_uint(ps), __float_as_uint(ps), false, false);
      ps = __uint_as_float(rr[0]) + __uint_as_float(rr[1]); }
    l_reg = l_reg * alpha + ps;
#define PK4(P, B_, OUT) do { unsigned a0 = cvtpk(P[B_+0], P[B_+1]), a1 = cvtpk(P[B_+2], P[B_+3]);                          \
        unsigned b0 = cvtpk(P[B_+4], P[B_+5]), b1 = cvtpk(P[B_+6], P[B_+7]);                                             \
        auto r0 = __builtin_amdgcn_permlane32_swap(a0, b0, false, false); auto r1 = __builtin_amdgcn_permlane32_swap(a1, b1, false, false); \
        u32x4 w = {r0[0], r1[0], r0[1], r1[1]}; OUT = *reinterpret_cast<bf16x8*>(&w); } while (0)
    PK4(p0, 0, pa0); PK4(p0, 8, pa1); PK4(p1, 0, pa2); PK4(p1, 8, pa3);
#undef PK4
}
template <int KB, bool SK>
__device__ __forceinline__ void qkt(f32x16& p0, f32x16& p1, const char* K_lds, int r32, int hi, const bf16x8* qr, bool act) {
    if (SK && !act) { const float NEG = -__builtin_inff();
#pragma unroll
        for (int r = 0; r < 16; ++r) { p0[r] = NEG; p1[r] = NEG; } return; }
    p0 = f32x16{}; p1 = f32x16{};
    const char* kb[4];
#pragma unroll
    for (int dd = 0; dd < 4; ++dd) kb[dd] = K_lds + KB * SHM_K + KSWZ(r32, (dd * 16 + hi * 8) * 2);
#pragma unroll
    for (int d0 = 0; d0 < 8; ++d0) { const char* a = kb[d0 & 3] + (d0 >> 2) * 128;
        bf16x8 b0 = *reinterpret_cast<const bf16x8*>(a);
        bf16x8 b1 = *reinterpret_cast<const bf16x8*>(a + 32 * 256);
        p0 = __builtin_amdgcn_mfma_f32_32x32x16_bf16(b0, qr[d0], p0, 0, 0, 0);
        p1 = __builtin_amdgcn_mfma_f32_32x32x16_bf16(b1, qr[d0], p1, 0, 0, 0); }
}
template <int VB, bool SK>
__device__ __forceinline__ void pv_tile(f32x16* o, int vb0, bf16x8 pa0, bf16x8 pa1, bf16x8 pa2, bf16x8 pa3, bool act) {
    if (SK && !act) return;
#define TRRD(dst, off) asm volatile("ds_read_b64_tr_b16 %0, %1 offset:%2" : "=&v"(dst) : "v"(vb0), "i"(off) : "memory")
#define PV_D0(d0) do { s16x4 l0, l1, l2, l3, h0, h1, h2, h3; constexpr int b_ = VB * SHM_V + v_rd_off(d0, 0, 0);     \
        TRRD(l0, b_); TRRD(h0, b_ + 2048); TRRD(l1, b_ + 4096); TRRD(h1, b_ + 6144); TRRD(l2, b_ + 8192); TRRD(h2, b_ + 10240); TRRD(l3, b_ + 12288); TRRD(h3, b_ + 14336); \
        asm volatile("s_waitcnt lgkmcnt(0)" ::: "memory"); SBAR();                 \
        o[d0] = __builtin_amdgcn_mfma_f32_32x32x16_bf16(pa0, (bf16x8){l0[0], l0[1], l0[2], l0[3], h0[0], h0[1], h0[2], h0[3]}, o[d0], 0, 0, 0);   \
        o[d0] = __builtin_amdgcn_mfma_f32_32x32x16_bf16(pa1, (bf16x8){l1[0], l1[1], l1[2], l1[3], h1[0], h1[1], h1[2], h1[3]}, o[d0], 0, 0, 0);   \
        o[d0] = __builtin_amdgcn_mfma_f32_32x32x16_bf16(pa2, (bf16x8){l2[0], l2[1], l2[2], l2[3], h2[0], h2[1], h2[2], h2[3]}, o[d0], 0, 0, 0);   \
        o[d0] = __builtin_amdgcn_mfma_f32_32x32x16_bf16(pa3, (bf16x8){l3[0], l3[1], l3[2], l3[3], h3[0], h3[1], h3[2], h3[3]}, o[d0], 0, 0, 0); } while (0)
    PV_D0(0); PV_D0(1); PV_D0(2); PV_D0(3);
#undef PV_D0
#undef TRRD
}
#define VMW() asm volatile("s_waitcnt vmcnt(0)" ::: "memory")
#define VMWN(n) asm volatile("s_waitcnt vmcnt(%0)" :: "i"(n) : "memory")
template <int KB>
__device__ __forceinline__ void qkt_mla(f32x16& p0, f32x16& p1, const char* K_lds, const char* KR_lds, int r32, int hi, const bf16x8* qr) {
    p0 = f32x16{}; p1 = f32x16{};
    const char* kb[4];
#pragma unroll
    for (int dd = 0; dd < 4; ++dd) kb[dd] = K_lds + KB * SHM_K + KSWZ(r32, (dd * 16 + hi * 8) * 2);
#pragma unroll
    for (int d0 = 0; d0 < 8; ++d0) { const char* a = kb[d0 & 3] + (d0 >> 2) * 128;
        bf16x8 b0 = *reinterpret_cast<const bf16x8*>(a);
        bf16x8 b1 = *reinterpret_cast<const bf16x8*>(a + 32 * 256);
        p0 = __builtin_amdgcn_mfma_f32_32x32x16_bf16(b0, qr[d0], p0, 0, 0, 0);
        p1 = __builtin_amdgcn_mfma_f32_32x32x16_bf16(b1, qr[d0], p1, 0, 0, 0); }
    const char* kr = KR_lds + KB * SHM_KR + r32 * 144 + hi * 16;
#pragma unroll
    for (int d0 = 0; d0 < 4; ++d0) {
        bf16x8 b0 = *reinterpret_cast<const bf16x8*>(kr + d0 * 32);
        bf16x8 b1 = *reinterpret_cast<const bf16x8*>(kr + d0 * 32 + 32 * 144);
        p0 = __builtin_amdgcn_mfma_f32_32x32x16_bf16(b0, qr[8 + d0], p0, 0, 0, 0);
        p1 = __builtin_amdgcn_mfma_f32_32x32x16_bf16(b1, qr[8 + d0], p1, 0, 0, 0); }
}
struct MlaRef { const bf16* Q; const bf16* K; const bf16* KR; const bf16* V; bf16* O; int P0; };
constexpr int MLA_OS = 1024;
#define MROW(p, k0, rr) ((p) + (size_t)((k0) + (rr)) * D + sc)
#define MSLOAD(R_, k0) do { st_v0 = load8<bf16>(MROW((R_).V, k0, sr)); st_v1 = load8<bf16>(MROW((R_).V, k0, 32 + sr));              \
                         st_k0 = load8<bf16>(MROW((R_).K, k0, sr)); st_k1 = load8<bf16>(MROW((R_).K, k0, 32 + sr));                \
                         st_kr = load8<bf16>((R_).KR + (size_t)((k0) + (tid >> 3)) * 64 + (tid & 7) * 8); } while (0)
#define MSWRITE(bf) do { *(bf16x8*)(V_lds + (bf) * SHM_V + vst0) = st_v0; *(bf16x8*)(V_lds + (bf) * SHM_V + vst1) = st_v1;               \
                         *(bf16x8*)(K_lds + (bf) * SHM_K + kws) = st_k0; *(bf16x8*)(K_lds + (bf) * SHM_K + kws + 32 * 256) = st_k1;       \
                         *(bf16x8*)(KR_lds + (bf) * SHM_KR + krws) = st_kr; } while (0)
__device__ __forceinline__ void mla_block(const MlaRef& cur, char* lds) {
    int tid_ = threadIdx.x; asm volatile("" : "+v"(tid_));
    const int tid = tid_, wid = __builtin_amdgcn_readfirstlane(tid >> 6), lane = tid & 63, r32 = lane & 31, hi = lane >> 5;
    const int NT = (cur.P0 + QB) / KVBLK;
    const int qlo = cur.P0 + wid * QBLK, qm = qlo + r32 - 4 * hi;
    char* V_lds = lds; char* K_lds = lds + 2 * SHM_V; char* KR_lds = lds + 2 * SHM_V + 2 * SHM_K;
    float* ws = (float*)(lds + 2 * SHM_V + 2 * SHM_K + 2 * SHM_KR) + wid * 64; float* li_l = ws, * al_l = ws + 32;
    float m_reg = -1e30f, l_reg = 0; f32x16 o[4] = {};
    const int sr = tid >> 4, sc = (tid & 15) * 8, vst0 = v_st(sr, sc), vst1 = v_st(32 + sr, sc), kws = KSWZ(sr, sc * 2), krws = (tid >> 3) * 144 + (tid & 7) * 16;
    const int vb0 = (int)(uintptr_t)V_lds + v_rd_base(lane);
    bf16x8 qr[12]; bf16x8 st_v0, st_v1, st_k0, st_k1, st_kr;
#pragma unroll
    for (int d0 = 0; d0 < 12; ++d0) qr[d0] = load8<bf16>(cur.Q + (size_t)(wid * QBLK + r32) * 192 + d0 * 16 + hi * 8);
    MSLOAD(cur, 0); VMW(); MSWRITE(0);
    __syncthreads();
    for (int t = 0; t < NT; ++t) {
        const int buf = t & 1, kb = t * KVBLK;
        if (t + 1 < NT) MSLOAD(cur, kb + KVBLK);
        if (kb <= qlo + QBLK - 1) {
            f32x16 p0, p1; float mn, alpha; bf16x8 pa0, pa1, pa2, pa3;
            SBAR(); qkt_mla<0>(p0, p1, K_lds + buf * SHM_K, KR_lds + buf * SHM_KR, r32, hi, qr);
            if (kb + KVBLK - 1 > qlo) mask_tile(p0, p1, qm - kb, 1u << 30);
            partialSM(p0, p1, m_reg, mn, alpha);
            if (__any(alpha < 1.f)) { if (hi == 0) al_l[r32] = alpha; asm volatile("s_waitcnt lgkmcnt(0)" ::: "memory");
#pragma unroll
                for (int d_ = 0; d_ < 4; ++d_)
#pragma unroll
                    for (int r = 0; r < 16; ++r) o[d_][r] *= al_l[crow(r, hi)]; }
            finishSM(p0, p1, alpha, l_reg, pa0, pa1, pa2, pa3); SBAR();
            pv_tile<0, false>(o, vb0 + buf * SHM_V, pa0, pa1, pa2, pa3, true);
        }
        if (t + 1 < NT) { VMW(); MSWRITE(buf ^ 1); }
        __syncthreads();
    }
    if (hi == 0) li_l[r32] = l_reg; asm volatile("s_waitcnt lgkmcnt(0)" ::: "memory");
    float rli[16];
#pragma unroll
    for (int r = 0; r < 16; ++r) rli[r] = __builtin_amdgcn_rcpf(li_l[crow(r, hi)]);
    bf16* Ow = cur.O + (size_t)(wid * QBLK) * MLA_OS;
#pragma unroll
    for (int r = 0; r < 16; ++r) { const int orow = crow(r, hi);
#pragma unroll
        for (int d0 = 0; d0 < 4; ++d0) { const float v = o[d0][r] * rli[r];
            const float vn = __shfl_xor(v, 1);
            if ((r32 & 1) == 0) *(unsigned*)(Ow + (size_t)orow * MLA_OS + d0 * 32 + r32) = cvtpk(v, vn); } }
    __syncthreads();
}
#undef MROW
#undef MSLOAD
#undef MSWRITE
constexpr float SB_STOP = -170.f;
constexpr int SB_OS = 1024;
__device__ __forceinline__ void sb_block(const bf16* Qb, const bf16* Kh, const bf16* Vh, bf16* Ob, int q0, char* lds) {
    int tid_ = threadIdx.x; asm volatile("" : "+v"(tid_));
    const int tid = tid_, wid = __builtin_amdgcn_readfirstlane(tid >> 6), lane = tid & 63, r32 = lane & 31, hi = lane >> 5;
    char* V_lds = lds; char* K_lds = lds + 2 * SHM_V; volatile __attribute__((address_space(3))) int* flags = (volatile __attribute__((address_space(3))) int*)(lds + 2 * SHM_V + 2 * SHM_K);
    const int sr = tid >> 4, sc = (tid & 15) * 8, vst0 = v_st(sr, sc), vst1 = v_st(32 + sr, sc), kws = KSWZ(sr, sc * 2);
    const int vb0 = (int)(uintptr_t)V_lds + v_rd_base(lane);
    bf16x8 qr[8];
#pragma unroll
    for (int d0 = 0; d0 < 8; ++d0) qr[d0] = load8<bf16>(Qb + (size_t)(wid * QBLK + r32) * D + d0 * 16 + hi * 8);
    const int qlo = q0 + wid * QBLK, trow = qlo + r32;
    float R = 0.f; f32x16 o[4] = {};
    bool wdone = false;
    bf16x8 st_v0, st_v1, st_k0, st_k1;
#define SBLOAD(k0) do { st_v0 = load8<bf16>(Vh + (size_t)((k0) + sr) * D + sc); st_v1 = load8<bf16>(Vh + (size_t)((k0) + 32 + sr) * D + sc); \
                        st_k0 = load8<bf16>(Kh + (size_t)((k0) + sr) * D + sc); st_k1 = load8<bf16>(Kh + (size_t)((k0) + 32 + sr) * D + sc); } while (0)
    int j = q0 / KVBLK + 3;
    SBLOAD(j * KVBLK);
    for (int it = 0; ; ++it, --j) {
        const int buf = it & 1;
        VMW();
        *(bf16x8*)(V_lds + buf * SHM_V + vst0) = st_v0; *(bf16x8*)(V_lds + buf * SHM_V + vst1) = st_v1;
        *(bf16x8*)(K_lds + buf * SHM_K + kws) = st_k0; *(bf16x8*)(K_lds + buf * SHM_K + kws + 32 * 256) = st_k1;
        __syncthreads();
        if (it > 0) { int all = 1;
#pragma unroll
            for (int w = 0; w < 8; ++w) all &= flags[((it - 1) & 1) * 8 + w];
            if (__builtin_amdgcn_readfirstlane(all)) break; }
        if (j > 0) SBLOAD((j - 1) * KVBLK);
        const int kb = j * KVBLK;
        const bool act = !wdone && (kb < qlo + QBLK - 1);
        if (act) {
            f32x16 p0, p1, l0, l1;
            qkt<0, false>(p0, p1, K_lds + buf * SHM_K, r32, hi, qr, true);
            const int dq = trow - kb - 4 * hi;
#pragma unroll
            for (int r = 0; r < 16; ++r) { const int c = (r & 3) + 8 * (r >> 2);
                const float z0 = p0[r], z1 = p1[r];
                const float a0 = -(fmaxf(z0, 0.f) + __builtin_amdgcn_logf(1.f + __builtin_amdgcn_exp2f(-fabsf(z0))));
                const float a1 = -(fmaxf(z1, 0.f) + __builtin_amdgcn_logf(1.f + __builtin_amdgcn_exp2f(-fabsf(z1))));
                l0[r] = (c < dq) ? a0 : 0.f; l1[r] = (c + 32 < dq) ? a1 : 0.f; }
            float gs[8], ot[8], E[8];
#pragma unroll
            for (int k = 0; k < 4; ++k) { gs[k] = (l0[4 * k] + l0[4 * k + 1]) + (l0[4 * k + 2] + l0[4 * k + 3]); gs[4 + k] = (l1[4 * k] + l1[4 * k + 1]) + (l1[4 * k + 2] + l1[4 * k + 3]); }
#pragma unroll
            for (int k = 0; k < 8; ++k) { const unsigned gu = __float_as_uint(gs[k]); auto rr = __builtin_amdgcn_permlane32_swap(gu, gu, false, false); ot[k] = __uint_as_float(hi ? rr[0] : rr[1]); }
            float acc = 0.f;
#pragma unroll
            for (int k = 7; k >= 0; --k) { E[k] = acc + (hi == 0 ? ot[k] : 0.f); acc += gs[k] + ot[k]; }
#pragma unroll
            for (int k = 0; k < 4; ++k) {
                float s0 = E[k] + R, s1 = E[4 + k] + R;
#pragma unroll
                for (int q = 3; q >= 0; --q) { const int r = 4 * k + q, c = (r & 3) + 8 * (r >> 2);
                    s0 += l0[r]; s1 += l1[r];
                    const float w0 = __builtin_amdgcn_exp2f(p0[r] + s0), w1 = __builtin_amdgcn_exp2f(p1[r] + s1);
                    p0[r] = (c < dq) ? w0 : 0.f; p1[r] = (c + 32 < dq) ? w1 : 0.f; }
            }
            R += acc;
            bf16x8 pa0, pa1, pa2, pa3;
#define PK4(P, B_, OUT) do { unsigned a0 = cvtpk(P[B_+0], P[B_+1]), a1 = cvtpk(P[B_+2], P[B_+3]);                          \
        unsigned b0 = cvtpk(P[B_+4], P[B_+5]), b1 = cvtpk(P[B_+6], P[B_+7]);                                             \
        auto r0 = __builtin_amdgcn_permlane32_swap(a0, b0, false, false); auto r1 = __builtin_amdgcn_permlane32_swap(a1, b1, false, false); \
        u32x4 w = {r0[0], r1[0], r0[1], r1[1]}; OUT = *reinterpret_cast<bf16x8*>(&w); } while (0)
            PK4(p0, 0, pa0); PK4(p0, 8, pa1); PK4(p1, 0, pa2); PK4(p1, 8, pa3);
#undef PK4
            SBAR();
            pv_tile<0, false>(o, vb0 + buf * SHM_V, pa0, pa1, pa2, pa3, true);
            wdone = __all(R < SB_STOP);
        }
        if (lane == 0) flags[(it & 1) * 8 + wid] = wdone ? 1 : 0;
        if (j == 0) break;
    }
#undef SBLOAD
    bf16* Ow = Ob + (size_t)(wid * QBLK) * SB_OS;
#pragma unroll
    for (int r = 0; r < 16; ++r) { const int orow = crow(r, hi);
#pragma unroll
        for (int d0 = 0; d0 < 4; ++d0) { const float v = o[d0][r];
            const float vn = __shfl_xor(v, 1);
            if ((r32 & 1) == 0) *(unsigned*)(Ow + (size_t)orow * SB_OS + d0 * 32 + r32) = cvtpk(v, vn); } }
    __syncthreads();
}
}
template <int KIND> __device__ __forceinline__ int srcmap(int n) {
    if constexpr (KIND == 1) {
        if (n < 4096) return n;
        if (n < 4160) { const int j = n - 4096; return 4096 + (j & 1) * 32 + (j >> 1); }
        if (n < 4352) return -1;
        return n - 192;
    } else if constexpr (KIND == 2) {
        const int h = n / 192, dd = n - h * 192;
        if (dd < 128) return n;
        const int j = dd - 128; return h * 192 + 128 + (j & 1) * 32 + (j >> 1);
    } else return n;
}
template <int KIND> __device__ __forceinline__ void tr_item(const float* __restrict__ W, int K, int Nsrc, const float* __restrict__ gk, bf16_t* WT, LAS float* scr, int item, int nblk, int lane) {
    const int kb = item / nblk, nb = item - kb * nblk, k0 = 64 * kb, n0 = 32 * nb;
    const int src = srcmap<KIND>(n0 + (lane & 31));
#pragma unroll 8
    for (int i = 0; i < 32; ++i) { const int kk = 2 * i + (lane >> 5); float v = 0.f; if (src >= 0) v = __builtin_nontemporal_load(&W[(size_t)(k0 + kk) * Nsrc + src]); if (gk) v *= gk[k0 + kk]; scr[kk * 33 + (lane & 31)] = v; }
    asm volatile("s_waitcnt lgkmcnt(0)" ::: "memory");
    const int c = lane & 7;
#pragma unroll
    for (int j = 0; j < 4; ++j) { const int n = (lane >> 3) + 8 * j; const LAS float* s = scr + (8 * c) * 33 + n;
        u32x4 o; o.x = pk2(s[0 * 33], s[1 * 33]); o.y = pk2(s[2 * 33], s[3 * 33]); o.z = pk2(s[4 * 33], s[5 * 33]); o.w = pk2(s[6 * 33], s[7 * 33]);
        *(u32x4*)(WT + (size_t)(n0 + n) * K + k0 + 8 * c) = o; }
    asm volatile("s_waitcnt lgkmcnt(0)" ::: "memory");
}

#ifndef PHASE_MASK
#define PHASE_MASK 0xFFFF
#endif
struct Params { const float* in[20]; float* out; unsigned char* ws; };

__global__ void __launch_bounds__(512, 2) fwd(Params P) {
    extern __shared__ __attribute__((aligned(16))) unsigned char lds_raw[];
    LAS unsigned char* lds = (LAS unsigned char*)lds_raw;
    const int tid = threadIdx.x, lane = tid & 63, wave = __builtin_amdgcn_readfirstlane(tid >> 6);
    const int G = gridDim.x, bx = blockIdx.x;
    const int vcu = (G % 8 == 0) ? (bx % 8) * (G / 8) + bx / 8 : bx;
    const int gw = vcu * 8 + wave, NGW = G * 8;
#define CAS __attribute__((address_space(4)))
#define KARG(off) ({ const CAS char* k_ = (const CAS char*)__builtin_amdgcn_kernarg_segment_ptr(); asm volatile("" : "+s"(k_)); *(const CAS unsigned long long*)(k_ + (off)); })
#define GAS __attribute__((address_space(1)))
#define INP(i) ((const float*)(const GAS float*)KARG(8 * (i)))
#define OUT_P ((float*)(GAS float*)KARG(160))
#define WS_P ((unsigned char*)(GAS unsigned char*)KARG(168))
#define X_IN INP(0)
#define P_IN INP(1)
#define POS_IN ((const int*)INP(2))
#define ssq_cq ((float*)(WS_P + WS_SSQ))
#define ssq_ckv (ssq_cq + T_TOK)
#define ssq_y (ssq_cq + 2 * T_TOK)
#define ssq_d (ssq_cq + 3 * T_TOK)
#define ssq_e (ssq_cq + 4 * T_TOK)
#define wb ((bf16_t*)(WS_P + WS_W))
#define XN ((bf16_t*)(WS_P + WS_XN))
#define SBQ ((bf16_t*)(WS_P + WS_SBQ))
#define SBK ((bf16_t*)(WS_P + WS_SBK))
#define SBV ((bf16_t*)(WS_P + WS_SBV))
#define CQ ((bf16_t*)(WS_P + WS_CQ))
#define CKV ((bf16_t*)(WS_P + WS_CKV))
#define QMLA ((bf16_t*)(WS_P + WS_QMLA))
#define KN ((bf16_t*)(WS_P + WS_KN))
#define VMLA ((bf16_t*)(WS_P + WS_VMLA))
#define KROPE ((bf16_t*)(WS_P + WS_KROPE))
#define OSB ((bf16_t*)(WS_P + WS_OSB))
#define OMLA ((bf16_t*)(WS_P + WS_OMLA))
#define EB ((bf16_t*)(WS_P + WS_E))
#define MIXED ((bf16_t*)(WS_P + WS_MIXED))
#define YB ((bf16_t*)(WS_P + WS_Y))
#define PB ((bf16_t*)(WS_P + WS_PB))
#define UB ((bf16_t*)(WS_P + WS_U))
#define DN ((bf16_t*)(WS_P + WS_DN))
#define SGS ((bf16_t*)OUT_P)
#define SGM (SGS + (size_t)T_TOK * DM)
    { volatile LAS unsigned* st0 = (volatile LAS unsigned*)(lds + 131072 + 64); if (tid == 0) { st0[0] = 0u; st0[1] = 0u; } __syncthreads(); }
    cg::this_grid().sync();
    const XcdBarrier xbar = xcd_barrier_post((unsigned*)(WS_P + WS_BAR), (volatile LAS unsigned*)(lds + 131072 + 64));
#define GRID_SYNC() xcd_barrier(xbar)

    if (PHASE_MASK & (1 << 0)) {
        for (int i = (bx * 512 + tid); i < 5 * T_TOK; i += G * 512) ssq_cq[i] = 0.f;
        LAS float* scr = (LAS float*)(lds + wave * 16384);
        constexpr int I0 = (2048 / 64) * (NIN / 32), I1 = (512 / 64) * (1536 / 32), I2 = (512 / 64) * (2048 / 32), I3 = (1024 / 64) * (2048 / 32), I4 = I3,
                      I5 = (2048 / 64) * (2048 / 32), I6 = (2048 / 64) * (8192 / 32), I7 = (8192 / 64) * (2048 / 32), I8 = (256 / 64) * (2048 / 32), I9 = I5;
        constexpr int NITEMS = I0 + I1 + I2 + I3 + I4 + I5 + I6 + I7 + I8 + I9;
        for (int it = gw; it < NITEMS; it += NGW) {
            int r = it;
            if (r < I0) { tr_item<1>(INP(4), 2048, 8256, nullptr, wb + OFF_WIN, scr, r, NIN / 32, lane); continue; } r -= I0;
            if (r < I1) { tr_item<2>(INP(7), 512, 1536, INP(5), wb + OFF_WQ, scr, r, 1536 / 32, lane); continue; } r -= I1;
            if (r < I2) { tr_item<0>(INP(8), 512, 2048, INP(6), wb + OFF_WKV, scr, r, 2048 / 32, lane); continue; } r -= I2;
            if (r < I3) { tr_item<0>(INP(9), 1024, 2048, nullptr, wb + OFF_WSBO, scr, r, 2048 / 32, lane); continue; } r -= I3;
            if (r < I4) { tr_item<0>(INP(10), 1024, 2048, nullptr, wb + OFF_WMLAO, scr, r, 2048 / 32, lane); continue; } r -= I4;
            if (r < I5) { tr_item<0>(INP(11), 2048, 2048, nullptr, wb + OFF_WOUT, scr, r, 2048 / 32, lane); continue; } r -= I5;
            if (r < I6) { tr_item<0>(INP(14), 2048, 8192, nullptr, wb + OFF_WUP, scr, r, 8192 / 32, lane); continue; } r -= I6;
            if (r < I7) { tr_item<0>(INP(15), 8192, 2048, nullptr, wb + OFF_WDOWN, scr, r, 2048 / 32, lane); continue; } r -= I7;
            if (r < I8) { tr_item<0>(INP(17), 256, 2048, nullptr, wb + OFF_WPLE, scr, r, 2048 / 32, lane); continue; } r -= I8;
            tr_item<0>(INP(19), 2048, 2048, nullptr, wb + OFF_WPG, scr, r, 2048 / 32, lane);
        }
        const f32x4* gr = (const f32x4*)INP(3) + lane;
        for (int m = gw; m < T_TOK; m += NGW) {
            const f32x4* xr = (const f32x4*)(X_IN + (size_t)m * DM) + lane; f32x4 v[8]; float s = 0.f;
#pragma unroll
            for (int j = 0; j < 8; ++j) { v[j] = __builtin_nontemporal_load(&xr[64 * j]); s += (v[j].x * v[j].x + v[j].y * v[j].y) + (v[j].z * v[j].z + v[j].w * v[j].w); }
            const float rs = __builtin_amdgcn_rsqf(wave_sum(s) * (1.f / DM) + EPS);
            u32x2* o = (u32x2*)(XN + (size_t)m * DM) + lane;
#pragma unroll
            for (int j = 0; j < 8; ++j) { const f32x4 g = gr[64 * j]; u32x2 w; w.x = pk2(v[j].x * rs * g.x, v[j].y * rs * g.y); w.y = pk2(v[j].z * rs * g.z, v[j].w * rs * g.w); o[64 * j] = w; }
        }
    }
    GRID_SYNC();

    if (PHASE_MASK & (1 << 1)) {
        pg8::Gemm g{XN, wb + OFF_WIN, T_TOK, NIN, 2048}; pg8::StaticOrder S; S.init(T_TOK, NIN, G, bx);
        Epi<EK_P1> E{}; E.a.o0 = SBQ; E.a.o1 = SBK; E.a.o2 = SBV; E.a.o3 = CQ; E.a.o4 = CKV; E.a.o5 = KROPE; E.a.o6 = SGS; E.a.o7 = SGM; E.a.ssq0 = ssq_cq; E.a.ssq1 = ssq_ckv; E.a.pos = POS_IN;
        pg8::gemm_phase<Epi<EK_P1>, pg8::StaticOrder, true, true>(lds, g, S, E);
    }
    GRID_SYNC();

    if (PHASE_MASK & (1 << 2)) {
        { pg8::Gemm g{CQ, wb + OFF_WQ, T_TOK, 1536, 512}; pg8::StaticOrder S; S.init(T_TOK, 1536, G, bx);
          Epi<EK_Q> E{}; E.a.o0 = QMLA; E.a.ssq0 = ssq_cq; E.a.pos = POS_IN;
          pg8::gemm_phase<Epi<EK_Q>, pg8::StaticOrder, true, true>(lds, g, S, E); }
        { pg8::Gemm g{CKV, wb + OFF_WKV, T_TOK, 2048, 512}; pg8::StaticOrder S; S.init(T_TOK, 2048, G, bx);
          Epi<EK_KV> E{}; E.a.o0 = KN; E.a.o1 = VMLA; E.a.ssq0 = ssq_ckv;
          pg8::gemm_phase<Epi<EK_KV>, pg8::StaticOrder, true, true>(lds, g, S, E); }
    }
    GRID_SYNC();

    if (PHASE_MASK & (1 << 3)) {
        char* al = (char*)lds_raw;
#ifndef REP_SB
#define REP_SB 1
#endif
#ifndef NO_SB
        for (int rep_ = 0; rep_ < REP_SB; ++rep_)
        for (int L = vcu; L < 32 * 32; L += G) {
            const int bh = L >> 5, qb = L & 31, b = bh >> 3, h = bh & 7;
            att::sb_block((const att::bf16*)SBQ + ((size_t)bh * SEQ + qb * 256) * 128, (const att::bf16*)SBK + (size_t)bh * SEQ * 128, (const att::bf16*)SBV + (size_t)bh * SEQ * 128,
                          (att::bf16*)OSB + ((size_t)(b * SEQ + qb * 256)) * 1024 + h * 128, qb * 256, al);
        }
#endif
#ifndef NO_MLA
#ifndef REP_MLA
#define REP_MLA 1
#endif
        for (int rep_ = 0; rep_ < REP_MLA; ++rep_)
        for (int L = vcu; L < 32 * 16; L += G) {
            const int bh = L >> 4, xq = L & 15, b = bh >> 3, h = bh & 7;
#pragma unroll 1
            for (int pass = 0; pass < 2; ++pass) { const int qb = pass ? xq : 31 - xq;
                att::MlaRef r; r.Q = (const att::bf16*)QMLA + ((size_t)bh * SEQ + qb * 256) * 192; r.K = (const att::bf16*)KN + (size_t)bh * SEQ * 128;
                r.KR = (const att::bf16*)KROPE + (size_t)b * SEQ * 64; r.V = (const att::bf16*)VMLA + (size_t)bh * SEQ * 128;
                r.O = (att::bf16*)OMLA + ((size_t)(b * SEQ + qb * 256)) * 1024 + h * 128; r.P0 = qb * 256;
                att::mla_block(r, al); }
        }
#endif
    }
    GRID_SYNC();

    if (PHASE_MASK & (1 << 4)) {
        { pg8::Gemm g{OSB, wb + OFF_WSBO, T_TOK, 2048, 1024}; pg8::StaticOrder S; S.init(T_TOK, 2048, G, bx);
          Epi<EK_MIX1> E{}; E.a.o0 = MIXED; E.a.g0 = SGS;
          pg8::gemm_phase<Epi<EK_MIX1>, pg8::StaticOrder, true, true>(lds, g, S, E); }
        { pg8::Gemm g{OMLA, wb + OFF_WMLAO, T_TOK, 2048, 1024}; pg8::StaticOrder S; S.init(T_TOK, 2048, G, bx);
          Epi<EK_MIX2> E{}; E.a.o0 = MIXED; E.a.g0 = SGM;
          pg8::gemm_phase<Epi<EK_MIX2>, pg8::StaticOrder, true, true>(lds, g, S, E); }
    }
    GRID_SYNC();

    if (PHASE_MASK & (1 << 5)) {
        pg8::Gemm g{MIXED, wb + OFF_WOUT, T_TOK, 2048, 2048}; pg8::StaticOrder S; S.init(T_TOK, 2048, G, bx);
        Epi<EK_SSQ> E{}; E.a.o0 = YB; E.a.ssq0 = ssq_y;
        pg8::gemm_phase<Epi<EK_SSQ>, pg8::StaticOrder, true, true>(lds, g, S, E);
    }
    GRID_SYNC();

    if (PHASE_MASK & (1 << 6)) {
        const f32x4* g1 = (const f32x4*)INP(12) + lane; const f32x4* g2 = (const f32x4*)INP(13) + lane;
        for (int m = gw; m < T_TOK; m += NGW) {
            const float rsy = __builtin_amdgcn_rsqf(ssq_y[m] * (1.f / DM) + EPS);
            const f32x4* xr = (const f32x4*)(X_IN + (size_t)m * DM) + lane; const u32x2* yr = (const u32x2*)(YB + (size_t)m * DM) + lane;
            f32x4* orow = (f32x4*)(OUT_P + (size_t)m * DM) + lane;
            f32x4 v[8]; float s = 0.f;
#pragma unroll
            for (int j = 0; j < 8; ++j) { const f32x4 xv = __builtin_nontemporal_load(&xr[64 * j]); const u32x2 yw = __builtin_nontemporal_load(&yr[64 * j]); const f32x4 g = g1[64 * j];
                f32x4 t; t.x = xv.x + bf_lo(yw.x) * rsy * g.x; t.y = xv.y + bf_hi(yw.x) * rsy * g.y; t.z = xv.z + bf_lo(yw.y) * rsy * g.z; t.w = xv.w + bf_hi(yw.y) * rsy * g.w;
                v[j] = t; __builtin_nontemporal_store(t, &orow[64 * j]); s += (t.x * t.x + t.y * t.y) + (t.z * t.z + t.w * t.w); }
            const float rs = __builtin_amdgcn_rsqf(wave_sum(s) * (1.f / DM) + EPS);
            u32x2* o = (u32x2*)(XN + (size_t)m * DM) + lane;
#pragma unroll
            for (int j = 0; j < 8; ++j) { const f32x4 g = g2[64 * j]; u32x2 w; w.x = pk2(v[j].x * rs * g.x, v[j].y * rs * g.y); w.y = pk2(v[j].z * rs * g.z, v[j].w * rs * g.w); o[64 * j] = w; }
            const f32x4 pv = ((const f32x4*)(P_IN + (size_t)m * PLE))[lane]; u32x2 pw; pw.x = pk2(pv.x, pv.y); pw.y = pk2(pv.z, pv.w);
            ((u32x2*)(PB + (size_t)m * PLE))[lane] = pw;
        }
    }
    GRID_SYNC();

    if (PHASE_MASK & (1 << 7)) {
#ifndef REP_UP
#define REP_UP 1
#endif
        for (int rep_ = 0; rep_ < REP_UP; ++rep_)
        { pg8::Gemm g{XN, wb + OFF_WUP, T_TOK, FF, 2048}; pg8::StaticOrder S; S.init(T_TOK, FF, G, bx);
          Epi<EK_UP> E{}; E.a.o0 = UB;
          pg8::gemm_phase<Epi<EK_UP>, pg8::StaticOrder, true, true>(lds, g, S, E); }
        { pg8::Gemm g{PB, wb + OFF_WPLE, T_TOK, 2048, 256}; pg8::StaticOrder S; S.init(T_TOK, 2048, G, bx);
          Epi<EK_SSQ> E{}; E.a.o0 = EB; E.a.ssq0 = ssq_e;
          pg8::gemm_phase<Epi<EK_SSQ>, pg8::StaticOrder, true, true>(lds, g, S, E); }
    }
    GRID_SYNC();

    if (PHASE_MASK & (1 << 8)) {
        pg8::Gemm g{UB, wb + OFF_WDOWN, T_TOK, 2048, FF}; pg8::StaticOrder S; S.init(T_TOK, 2048, G, bx);
        Epi<EK_SSQ> E{}; E.a.o0 = DN; E.a.ssq0 = ssq_d;
        pg8::gemm_phase<Epi<EK_SSQ>, pg8::StaticOrder, true, true>(lds, g, S, E);
    }
    GRID_SYNC();

    if (PHASE_MASK & (1 << 9)) {
        const f32x4* g1 = (const f32x4*)INP(16) + lane;
        for (int m = gw; m < T_TOK; m += NGW) {
            const float rsd = __builtin_amdgcn_rsqf(ssq_d[m] * (1.f / DM) + EPS);
            const u32x2* dr = (const u32x2*)(DN + (size_t)m * DM) + lane;
            f32x4* orow = (f32x4*)(OUT_P + (size_t)m * DM) + lane; u32x2* o = (u32x2*)(XN + (size_t)m * DM) + lane;
#pragma unroll
            for (int j = 0; j < 8; ++j) { const f32x4 xv = __builtin_nontemporal_load(&orow[64 * j]); const u32x2 dw = __builtin_nontemporal_load(&dr[64 * j]); const f32x4 g = g1[64 * j];
                f32x4 t; t.x = xv.x + bf_lo(dw.x) * rsd * g.x; t.y = xv.y + bf_hi(dw.x) * rsd * g.y; t.z = xv.z + bf_lo(dw.y) * rsd * g.z; t.w = xv.w + bf_hi(dw.y) * rsd * g.w;
                __builtin_nontemporal_store(t, &orow[64 * j]); u32x2 w; w.x = pk2(t.x, t.y); w.y = pk2(t.z, t.w); o[64 * j] = w; }
        }
    }
    GRID_SYNC();

    if (PHASE_MASK & (1 << 10)) {
        pg8::Gemm g{XN, wb + OFF_WPG, T_TOK, 2048, 2048}; pg8::StaticOrder S; S.init(T_TOK, 2048, G, bx);
        Epi<EK_FIN> E{}; E.a.g0 = EB; E.a.ssq0 = ssq_e; E.a.outf = OUT_P; E.a.gv = INP(18);
        pg8::gemm_phase<Epi<EK_FIN>, pg8::StaticOrder, true, true>(lds, g, S, E);
    }
}

extern "C" void kernel_launch(void* const* d_in, const int* in_sizes, int n_in, void* d_out, int out_size, void* d_ws, size_t ws_size, hipStream_t stream) {
    static int grid_blocks = 0;
    if (grid_blocks == 0) {
        if (n_in != 20 || out_size != T_TOK * DM || ws_size < WS_END) { fprintf(stderr, "kernel_launch: unexpected shapes (n_in %d out %d ws %zu)\n", n_in, out_size, ws_size); grid_blocks = -1; return; }
        int dev = 0, cus = 0, per_cu = 0;
        (void)hipGetDevice(&dev); (void)hipDeviceGetAttribute(&cus, hipDeviceAttributeMultiprocessorCount, dev);
        (void)hipFuncSetAttribute((const void*)fwd, hipFuncAttributeMaxDynamicSharedMemorySize, LDS_BYTES);
        (void)hipOccupancyMaxActiveBlocksPerMultiprocessor(&per_cu, (const void*)fwd, 512, LDS_BYTES);
        if (per_cu < 1) { fprintf(stderr, "kernel_launch: occupancy query says %d blocks per CU\n", per_cu); per_cu = 1; }
        grid_blocks = cus * per_cu;
    }
    if (grid_blocks < 0) return;
    (void)hipMemsetAsync((char*)d_ws + WS_BAR, 0, 16384, stream);
    Params p{};
    for (int i = 0; i < 20; ++i) p.in[i] = (const float*)d_in[i];
    p.out = (float*)d_out; p.ws = (unsigned char*)d_ws;
    void* args[] = {&p};
    hipError_t e = hipLaunchCooperativeKernel((const void*)fwd, dim3(grid_blocks), dim3(512), args, LDS_BYTES, stream);
    if (e != hipSuccess) fprintf(stderr, "cooperative launch failed: %s (grid %d)\n", hipGetErrorString(e), grid_blocks);
}
```
